# Optimizing an MI355X kernel written in HIP

```python
import jax, jax.numpy as jnp
from jax import lax
import numpy as np

D_MODEL = 1024
BATCH = 8
SEQ = 4096
DEPTH = 4
DEC_BATCH = 4
DEC_SEQ = 8192
PAST_LEN = 128

HEAD_DIM = 64
N_HEADS = D_MODEL // 2 // HEAD_DIM
N_KV = 2
GROUP = N_HEADS // N_KV
ATT_W = N_HEADS * HEAD_DIM
KV_W = N_KV * HEAD_DIM
N_FG = 4
FG_W = 128
FOUR_W = N_FG * FG_W
N_BRANCH = 2
IN_COLS = ATT_W + 2 * KV_W + FOUR_W + N_BRANCH * D_MODEL
D_FF = 2816
WINDOW = 128
BLOCK = 128
EPS = 1e-6
NEG = -1e30

kernel_name = "hybrid_swa_fnet_macaron_encoder"


def rmsnorm(x, g):
    xf = x.astype(jnp.float32)
    y = xf * lax.rsqrt(jnp.mean(xf * xf, axis=-1, keepdims=True) + EPS)
    return (y * g.astype(jnp.float32)).astype(x.dtype)


def swiglu(h, w_in, w_out):
    gu = h @ w_in
    g, u = jnp.split(gu, 2, axis=-1)
    return (jax.nn.silu(g) * u) @ w_out


def alibi_slopes():
    s = np.power(2.0, -8.0 * (np.arange(N_HEADS) + 1) / N_HEADS).astype(np.float32)
    return jnp.asarray(s).reshape(N_KV, GROUP)


def windowed_gqa(q, k, v, q_gain, k_gain, sink):
    B, S = q.shape[0], q.shape[1]
    nb = S // BLOCK
    q = rmsnorm(q, q_gain) * jnp.asarray(HEAD_DIM ** -0.5, q.dtype)
    k = rmsnorm(k, k_gain)
    qb = q.reshape(B, nb, BLOCK, N_KV, GROUP, HEAD_DIM)
    pad = ((0, 0), (BLOCK, BLOCK), (0, 0), (0, 0))
    kp = jnp.pad(k, pad).reshape(B, nb + 2, BLOCK, N_KV, HEAD_DIM)
    vp = jnp.pad(v, pad).reshape(B, nb + 2, BLOCK, N_KV, HEAD_DIM)
    kw = jnp.concatenate([kp[:, :-2], kp[:, 1:-1], kp[:, 2:]], axis=2)
    vw = jnp.concatenate([vp[:, :-2], vp[:, 1:-1], vp[:, 2:]], axis=2)
    s = jnp.einsum('bnqkgd,bnskd->bnkgqs', qb, kw,
                   preferred_element_type=jnp.float32)
    qi = jnp.arange(BLOCK)
    si = jnp.arange(3 * BLOCK)
    dist = jnp.abs(qi[:, None] + BLOCK - si[None, :])
    key_pos = jnp.arange(nb)[:, None] * BLOCK - BLOCK + si[None, :]
    valid = (dist <= WINDOW)[None, :, :] & ((key_pos >= 0) & (key_pos < S))[:, None, :]
    slopes = alibi_slopes()[:, :, None, None]
    s = s - slopes * dist.astype(jnp.float32)
    s = jnp.where(valid[None, :, None, None], s, NEG)
    sink_l = sink.astype(jnp.float32).reshape(N_KV, GROUP)[:, :, None, None]
    m = jnp.maximum(jnp.max(s, axis=-1, keepdims=True), sink_l)
    p = jnp.exp(s - m)
    denom = jnp.sum(p, axis=-1, keepdims=True) + jnp.exp(sink_l - m)
    p = (p / denom).astype(v.dtype)
    o = jnp.einsum('bnkgqs,bnskd->bnqkgd', p, vw)
    return o.reshape(B, S, ATT_W)


def fourier_mix(f):
    B, S = f.shape[0], f.shape[1]
    fg = f.reshape(B, S, N_FG, FG_W).astype(jnp.float32)
    out = jnp.fft.fft2(fg, axes=(1, 3), norm='ortho').real
    return out.reshape(B, S, FOUR_W).astype(f.dtype)


def encoder_layer(x, ln_ffn1, w_ffn1_in, w_ffn1_out, ln_mix, w_in, q_gain, k_gain,
                  sink, w_attn_br, w_four_br, w_out, ln_ffn2, w_ffn2_in, w_ffn2_out):
    B, S, _ = x.shape
    half = jnp.asarray(0.5, x.dtype)
    x = x + half * swiglu(rmsnorm(x, ln_ffn1), w_ffn1_in, w_ffn1_out)
    h = rmsnorm(x, ln_mix)
    z = h @ w_in
    o1 = ATT_W
    o2 = o1 + KV_W
    o3 = o2 + KV_W
    o4 = o3 + FOUR_W
    o5 = o4 + D_MODEL
    q = z[..., :o1].reshape(B, S, N_HEADS, HEAD_DIM)
    k = z[..., o1:o2].reshape(B, S, N_KV, HEAD_DIM)
    v = z[..., o2:o3].reshape(B, S, N_KV, HEAD_DIM)
    f = z[..., o3:o4]
    g_a = jax.nn.sigmoid(z[..., o4:o5])
    g_f = jax.nn.sigmoid(z[..., o5:])
    a = windowed_gqa(q, k, v, q_gain, k_gain, sink) @ w_attn_br
    fo = fourier_mix(f) @ w_four_br
    x = x + (g_a * a + g_f * fo) @ w_out
    x = x + half * swiglu(rmsnorm(x, ln_ffn2), w_ffn2_in, w_ffn2_out)
    return x


def trunk(x, ln_ffn1, w_ffn1_in, w_ffn1_out, ln_mix, w_in, q_gain, k_gain, sink,
          w_attn_br, w_four_br, w_out, ln_ffn2, w_ffn2_in, w_ffn2_out):
    for l in range(DEPTH):
        x = encoder_layer(x, ln_ffn1[l], w_ffn1_in[l], w_ffn1_out[l], ln_mix[l], w_in[l],
                          q_gain[l], k_gain[l], sink[l], w_attn_br[l], w_four_br[l],
                          w_out[l], ln_ffn2[l], w_ffn2_in[l], w_ffn2_out[l])
    return x


def setup_inputs(seed: int = 0) -> dict:
    key = jax.random.key(seed)
    ks = jax.random.split(key, 20)
    f32 = jnp.float32

    def w(k, shape, fan_in):
        return jax.random.normal(k, shape, f32) * (fan_in ** -0.5)

    def gain(k, shape):
        return 1.0 + 0.02 * jax.random.normal(k, shape, f32)

    return {
        'x_prompt': jax.random.normal(ks[0], (BATCH, SEQ, D_MODEL), f32),
        'x_sample': jax.random.normal(ks[1], (DEC_BATCH, DEC_SEQ, D_MODEL), f32),
        'ln_ffn1': gain(ks[2], (DEPTH, D_MODEL)),
        'w_ffn1_in': w(ks[3], (DEPTH, D_MODEL, 2 * D_FF), D_MODEL),
        'w_ffn1_out': w(ks[4], (DEPTH, D_FF, D_MODEL), D_FF),
        'ln_mix': gain(ks[5], (DEPTH, D_MODEL)),
        'w_in': w(ks[6], (DEPTH, D_MODEL, IN_COLS), D_MODEL),
        'q_gain': gain(ks[7], (DEPTH, HEAD_DIM)),
        'k_gain': gain(ks[8], (DEPTH, HEAD_DIM)),
        'sink': 0.5 * jax.random.normal(ks[9], (DEPTH, N_HEADS), f32),
        'w_attn_br': w(ks[10], (DEPTH, ATT_W, D_MODEL), ATT_W),
        'w_four_br': w(ks[11], (DEPTH, FOUR_W, D_MODEL), FOUR_W),
        'w_out': w(ks[12], (DEPTH, D_MODEL, D_MODEL), D_MODEL),
        'ln_ffn2': gain(ks[13], (DEPTH, D_MODEL)),
        'w_ffn2_in': w(ks[14], (DEPTH, D_MODEL, 2 * D_FF), D_MODEL),
        'w_ffn2_out': w(ks[15], (DEPTH, D_FF, D_MODEL), D_FF),
    }


def reference(x_prompt, x_sample, ln_ffn1, w_ffn1_in, w_ffn1_out, ln_mix, w_in,
              q_gain, k_gain, sink, w_attn_br, w_four_br, w_out, ln_ffn2,
              w_ffn2_in, w_ffn2_out):
    y_prompt = trunk(x_prompt, ln_ffn1, w_ffn1_in, w_ffn1_out, ln_mix, w_in, q_gain,
                     k_gain, sink, w_attn_br, w_four_br, w_out, ln_ffn2, w_ffn2_in,
                     w_ffn2_out)
    y_sample = trunk(x_sample, ln_ffn1, w_ffn1_in, w_ffn1_out, ln_mix, w_in, q_gain,
                     k_gain, sink, w_attn_br, w_four_br, w_out, ln_ffn2, w_ffn2_in,
                     w_ffn2_out)
    return (y_prompt, y_sample)
```

```cpp
#include <hip/hip_runtime.h>
#include <hip/hip_cooperative_groups.h>
#include <cstdio>
#include <cstdint>
namespace cg = cooperative_groups;

#define LAS __attribute__((address_space(3)))
typedef unsigned short bf16_t;
typedef short bf16x8 __attribute__((ext_vector_type(8)));
typedef float f32x4 __attribute__((ext_vector_type(4)));
typedef unsigned u32x4 __attribute__((ext_vector_type(4)));
typedef unsigned u32x2 __attribute__((ext_vector_type(2)));
typedef float f32x2v __attribute__((ext_vector_type(2)));

constexpr int DM = 1024, DFF = 2816, NHEADS = 8, DEPTH = 4;
constexpr int MT = 65536, MH = 32768;
constexpr int WIN_COLS = 3328;
constexpr float EPS = 1e-6f;

constexpr size_t MiB = (size_t)1 << 20;
constexpr size_t WS_SSQ = 1 * MiB;
constexpr size_t WS_W1 = 5 * MiB;
constexpr size_t WS_W2A = WS_W1 + 128 * 1024;
constexpr size_t WS_W2B = WS_W2A + 256 * 1024;
constexpr size_t WS_WT = 8 * MiB;
constexpr size_t WT_FFN_IN0 = 0, WT_FFN_OUT0 = 11 * MiB, WT_WIN = 16 * MiB + 512 * 1024, WT_PQ = 22 * MiB, WT_ABR = 24 * MiB,
                 WT_FBR = 25 * MiB, WT_WOUT = 26 * MiB, WT_FFN_IN1 = 28 * MiB, WT_FFN_OUT1 = 39 * MiB;
constexpr size_t WS_XB = 56 * MiB;
constexpr size_t WS_R = 184 * MiB;
constexpr size_t R_H = 0, R_QKV = 0, R_GA = 48 * MiB, R_GF = 112 * MiB, R_D0 = 176 * MiB, R_T1 = 240 * MiB, R_AO = 304 * MiB;
constexpr size_t WS_END = WS_R + 368 * MiB;

constexpr int LDS_BYTES = 155648;
constexpr int LDS_RS = 131072 + 4096;
constexpr int LDS_MISC = 131072 + 2048;
constexpr size_t WS_CTL = 0, CTL_BYTES = 16384;
constexpr int LDS_TAB = 131072;

__device__ __forceinline__ unsigned cvt_pk_bf16(float lo, float hi) { unsigned r; asm volatile("v_cvt_pk_bf16_f32 %0, %1, %2" : "=v"(r) : "v"(lo), "v"(hi)); return r; }
__device__ __forceinline__ u32x4 pack8(f32x4 a, f32x4 b) { u32x4 w; w.x = cvt_pk_bf16(a[0], a[1]); w.y = cvt_pk_bf16(a[2], a[3]); w.z = cvt_pk_bf16(b[0], b[1]); w.w = cvt_pk_bf16(b[2], b[3]); return w; }
__device__ __forceinline__ void unpack8(u32x4 w, f32x4& a, f32x4& b) {
    a[0] = __uint_as_float(w.x << 16); a[1] = __uint_as_float(w.x & 0xffff0000u); a[2] = __uint_as_float(w.y << 16); a[3] = __uint_as_float(w.y & 0xffff0000u);
    b[0] = __uint_as_float(w.z << 16); b[1] = __uint_as_float(w.z & 0xffff0000u); b[2] = __uint_as_float(w.w << 16); b[3] = __uint_as_float(w.w & 0xffff0000u);
}
__device__ __forceinline__ unsigned f2bf(float f) { unsigned u = __float_as_uint(f); return (u + 0x7fffu + ((u >> 16) & 1u)) >> 16; }
__device__ __forceinline__ float cos_rev(float x) { return __builtin_amdgcn_cosf(x); }
__device__ __forceinline__ float sin_rev(float x) { return __builtin_amdgcn_sinf(x); }
__device__ __forceinline__ float sigmoidf_(float x) { return __builtin_amdgcn_rcpf(1.0f + __expf(-x)); }
__device__ __forceinline__ float row_rs(const float* ssq, size_t row) {
    const f32x4* p = (const f32x4*)(ssq + row * 16);
    const f32x4 a = p[0], b = p[1], c = p[2], d = p[3];
    const float s = ((a[0] + a[1]) + (a[2] + a[3])) + ((b[0] + b[1]) + (b[2] + b[3])) + ((c[0] + c[1]) + (c[2] + c[3])) + ((d[0] + d[1]) + (d[2] + d[3]));
    return rsqrtf(s * (1.0f / 1024.0f) + EPS);
}

__device__ __forceinline__ void rows_rs8(const float* ssq, int row0, int fq, float (&rs)[2][4]) {
    f32x4 p[2][4];
#pragma unroll
    for (int ai = 0; ai < 2; ++ai)
#pragma unroll
        for (int m = 0; m < 4; ++m) p[ai][m] = *(const f32x4*)(ssq + (size_t)(row0 + ai * 128 + m * 16) * 16 + fq * 4);
#pragma unroll
    for (int ai = 0; ai < 2; ++ai)
#pragma unroll
        for (int m = 0; m < 4; ++m) { float s = (p[ai][m][0] + p[ai][m][1]) + (p[ai][m][2] + p[ai][m][3]); s += __shfl_xor(s, 16); s += __shfl_xor(s, 32); rs[ai][m] = rsqrtf(s * (1.0f / 1024.0f) + EPS); }
    asm volatile("" ::: "memory");
}
__device__ __forceinline__ void rows_rs8_lds(const LAS unsigned char* lds, int rt0, int fq, float (&rs)[2][4]) {
    const LAS f32x4* rp = (const LAS f32x4*)(lds + LDS_RS);
#pragma unroll
    for (int ai = 0; ai < 2; ++ai)
#pragma unroll
        for (int m = 0; m < 4; ++m) { const f32x4 p = rp[(rt0 + ai * 128 + m * 16) * 4 + fq]; float s = (p[0] + p[1]) + (p[2] + p[3]); s += __shfl_xor(s, 16); s += __shfl_xor(s, 32); rs[ai][m] = rsqrtf(s * (1.0f / 1024.0f) + EPS); }
}
__device__ __forceinline__ float wave_sum(float v) {
#pragma unroll
    for (int o = 1; o < 64; o <<= 1) v += __shfl_xor(v, o);
    return v;
}

namespace pg8 {
constexpr int BM = 256, BK = 64, HALF = 128, HTB = HALF * BK * 2, STAGE_BYTES = 8 * HTB, NXCD = 8, WGM = 8;
__host__ __device__ __forceinline__ int lds_byte(int r, int c) { const int st = (r >> 4) * 2 + (c >> 5), rr = r & 15, cc = c & 31, ob = rr * 64 + cc * 2; return st * 1024 + (ob ^ (((ob >> 9) & 1) << 5)); }
__host__ __device__ __forceinline__ void stage_rc(int b, int& R, int& C) { const int st = b / 1024, sb = b % 1024, swz = sb ^ (((sb >> 9) & 1) << 5); R = (st >> 1) * 16 + swz / 64; C = (st & 1) * 32 + (swz % 64) / 2; }
__host__ __device__ __forceinline__ int perm32(int rho) { const int n = rho >> 4, i = rho & 15; return 8 * (i >> 2) + 4 * n + (i & 3); }

struct Unit { int pm, pn; size_t offA, offB; };
struct Gemm { const bf16_t* A; const bf16_t* Bt; int lda, ldb; size_t hstepA, hstepB; int K; };

struct StdOrder {
    int nM, nN, nwg, G, c; size_t tA, tB;
    __device__ void init(int M, int N, int G_, int c_, int lda, int ldb) { nM = M / BM; nN = N / BM; nwg = nM * nN; G = G_; c = c_; tA = (size_t)BM * lda * 2; tB = (size_t)BM * ldb * 2; }
    __device__ bool next(int i, Unit& u) const {
        const long L = (long)i * G + c; if (L >= nwg) return false;
        int wgid = (int)L; { const int q = nwg / NXCD, r = nwg % NXCD, xcd = wgid % NXCD, off = wgid / NXCD; wgid = (xcd < r ? xcd * (q + 1) : r * (q + 1) + (xcd - r) * q) + off; }
        const int nig = WGM * nN, gid = wgid / nig, fm = gid * WGM, gsz = (nM - fm) < WGM ? (nM - fm) : WGM;
        u.pm = fm + ((wgid % nig) % gsz); u.pn = (wgid % nig) / gsz; u.offA = (size_t)u.pm * tA; u.offB = (size_t)u.pn * tB; return true;
    }
};

template <class Epi, class Sched>
__device__ __forceinline__ void gemm_phase(LAS unsigned char* lds, const Gemm g, const Sched& S, const Epi& E) {
    int tid_ = threadIdx.x; asm volatile("" : "+v"(tid_));
    const int tid = tid_, wid = __builtin_amdgcn_readfirstlane(tid >> 6), lane = tid & 63, wr = wid >> 2, wc = wid & 3, fr = lane & 15, fq = lane >> 4;
    int K_ = g.K; asm volatile("" : "+s"(K_));
    const int K = K_, nt = K / BK;
    unsigned voffA[2], voffB[2];
#pragma unroll
    for (int i = 0; i < 2; ++i) { int R, C; stage_rc(tid * 16 + i * 8192, R, C); const int Rb = Epi::PERM ? ((R & ~31) + perm32(R & 31)) : R;
        voffA[i] = (unsigned)(R * g.lda + C) * 2u; voffB[i] = (unsigned)(Rb * g.ldb + C) * 2u; }
    const size_t kstep = (size_t)(BK * 2);
    const size_t hsA = g.hstepA, hsB = g.hstepB;
    const unsigned ldsw = (unsigned)wid * 1024u;
    const int aoff = lds_byte(wr * 64 + fr, fq * 8), boff = lds_byte(wc * 32 + fr, fq * 8);
#define PG8_SA(b, h) (((b) * 2 + (h)) * HTB)
#define PG8_SB(b, h) ((4 + (b) * 2 + (h)) * HTB)
#define PG8_STAGE(bufoff, gbase, voff) do { _Pragma("unroll") for (int _i = 0; _i < 2; ++_i) \
        __builtin_amdgcn_global_load_lds((const unsigned*)((const char*)(gbase) + (voff)[_i]), (LAS unsigned*)(lds + (bufoff) + ldsw + _i * 8192), 16, 0, 0); } while (0)
#define PG8_LDA(dst, b, h) do { _Pragma("unroll") for (int m = 0; m < 4; ++m) _Pragma("unroll") for (int k = 0; k < 2; ++k) dst[m][k] = *(const LAS bf16x8*)(lds + PG8_SA(b, h) + aoff + m * 2048 + k * 1024); } while (0)
#define PG8_LDB(dst, b, h) do { _Pragma("unroll") for (int n = 0; n < 2; ++n) _Pragma("unroll") for (int k = 0; k < 2; ++k) dst[n][k] = *(const LAS bf16x8*)(lds + PG8_SB(b, h) + boff + n * 2048 + k * 1024); } while (0)
#define PG8_MMA(ai, bj, At, Bt) do { __builtin_amdgcn_s_setprio(1); _Pragma("unroll") for (int m = 0; m < 4; ++m) _Pragma("unroll") for (int n = 0; n < 2; ++n) _Pragma("unroll") for (int k = 0; k < 2; ++k) \
        acc[ai][bj][m][n] = __builtin_amdgcn_mfma_f32_16x16x32_bf16(Bt[n][k], At[m][k], acc[ai][bj][m][n], 0, 0, 0); __builtin_amdgcn_s_setprio(0); } while (0)
#define PG8_WAIT_V(n) asm volatile("s_waitcnt vmcnt(" #n ")" ::: "memory")
#define PG8_WAIT_L(n) asm volatile("s_waitcnt lgkmcnt(" #n ")" ::: "memory")
#define PG8_BAR __builtin_amdgcn_s_barrier()
#define PG8_SCHED __builtin_amdgcn_sched_barrier(0)
#define PG8_RSPF(un) do { const char* _s = (const char*)E.ssq + (size_t)(un).pm * (256 * 64) + (size_t)tid * 16; \
        __builtin_amdgcn_global_load_lds((const unsigned*)_s, (LAS unsigned*)(lds + LDS_RS + ldsw), 16, 0, 0); \
        __builtin_amdgcn_global_load_lds((const unsigned*)(_s + 8192), (LAS unsigned*)(lds + LDS_RS + 8192 + ldsw), 16, 0, 0); } while (0)
    Unit cur, nxt; int ui = 0;
    if (!S.next(0, cur)) return;
    if constexpr (Epi::RSPF) PG8_RSPF(cur);
    f32x4 acc[2][2][4][2];
#pragma unroll
    for (int a = 0; a < 2; ++a)
#pragma unroll
        for (int b = 0; b < 2; ++b)
#pragma unroll
            for (int m = 0; m < 4; ++m)
#pragma unroll
                for (int n = 0; n < 2; ++n) acc[a][b][m][n] = (f32x4){0.f, 0.f, 0.f, 0.f};
    bf16x8 At[4][2], B0[2][2], B1[2][2];
    const char* cA = (const char*)g.A + cur.offA; const char* cB = (const char*)g.Bt + cur.offB;
    PG8_STAGE(PG8_SB(0, 0), cB, voffB); PG8_STAGE(PG8_SB(0, 1), cB + hsB, voffB); PG8_STAGE(PG8_SA(0, 0), cA, voffA); PG8_STAGE(PG8_SA(0, 1), cA + hsA, voffA);
    if (wr == 1) PG8_BAR;
    PG8_WAIT_V(2); PG8_BAR;
    PG8_STAGE(PG8_SB(1, 0), cB + kstep, voffB); PG8_STAGE(PG8_SA(1, 0), cA + kstep, voffA); PG8_STAGE(PG8_SB(1, 1), cB + hsB + kstep, voffB);
    PG8_WAIT_V(6); PG8_BAR;
    for (;;) {
        const bool has_next = S.next(ui + 1, nxt);
        const char* nA = has_next ? (const char*)g.A + nxt.offA : cA; const char* nB = has_next ? (const char*)g.Bt + nxt.offB : cB;
        for (int t = 0; t < nt; t += 2) {
            const bool last = (t == nt - 2);
            const char* a1 = cA + (size_t)(t + 1) * kstep;
            const char* a2 = last ? nA : cA + (size_t)(t + 2) * kstep; const char* b2 = last ? nB : cB + (size_t)(t + 2) * kstep;
            const char* a3 = a2 + kstep; const char* b3 = b2 + kstep;
            if constexpr (Epi::MIDK) { if (t == (nt >> 1)) { int fr_ = fr, fq_ = fq; asm volatile("" : "+v"(fr_), "+v"(fq_)); E.mid(acc, cur, wr, wc, fr_, fq_); } }
            PG8_LDB(B0, 0, 0); PG8_LDB(B1, 0, 1); PG8_SCHED; PG8_LDA(At, 0, 0); PG8_STAGE(PG8_SA(1, 1), a1 + hsA, voffA);
            PG8_WAIT_V(8); PG8_WAIT_L(0); PG8_BAR; PG8_MMA(0, 0, At, B0); PG8_MMA(0, 1, At, B1); PG8_BAR; PG8_SCHED;
            PG8_LDA(At, 0, 1); PG8_STAGE(PG8_SB(0, 0), b2, voffB); PG8_STAGE(PG8_SB(0, 1), b2 + hsB, voffB); PG8_STAGE(PG8_SA(0, 0), a2, voffA);
            PG8_WAIT_V(8); PG8_WAIT_L(0); PG8_BAR; PG8_MMA(1, 0, At, B0); PG8_MMA(1, 1, At, B1); PG8_BAR; PG8_SCHED;
            PG8_LDB(B0, 1, 0); PG8_LDB(B1, 1, 1); PG8_SCHED; PG8_LDA(At, 1, 0); PG8_STAGE(PG8_SA(0, 1), a2 + hsA, voffA);
            PG8_WAIT_V(8); PG8_WAIT_L(0); PG8_BAR; PG8_MMA(0, 0, At, B0); PG8_MMA(0, 1, At, B1); PG8_BAR; PG8_SCHED;
            PG8_LDA(At, 1, 1); PG8_STAGE(PG8_SB(1, 0), b3, voffB); PG8_STAGE(PG8_SB(1, 1), b3 + hsB, voffB); PG8_STAGE(PG8_SA(1, 0), a3, voffA);
            PG8_WAIT_V(8); PG8_WAIT_L(0); PG8_BAR; PG8_MMA(1, 0, At, B0); PG8_MMA(1, 1, At, B1); PG8_BAR; PG8_SCHED;
        }
        if (wr == 0) PG8_BAR;
        { int fr_ = fr, fq_ = fq; asm volatile("" : "+v"(fr_), "+v"(fq_));
          if constexpr (Epi::RSPF) {
              float rsv[2][4]; rows_rs8_lds(lds, wr * 64 + fr_, fq_, rsv);
              PG8_WAIT_L(0); PG8_BAR;
              if (has_next) PG8_RSPF(nxt);
              E(acc, cur, wr, wc, fr_, fq_, rsv);
          } else E(acc, cur, wr, wc, fr_, fq_); }
        if (!has_next) break;
#pragma unroll
        for (int a = 0; a < 2; ++a)
#pragma unroll
            for (int b = 0; b < 2; ++b)
#pragma unroll
                for (int m = 0; m < 4; ++m)
#pragma unroll
                    for (int n = 0; n < 2; ++n) acc[a][b][m][n] = (f32x4){0.f, 0.f, 0.f, 0.f};
        cur = nxt; cA = nA; cB = nB; ++ui;
        if (wr == 1) PG8_BAR;
    }
    PG8_WAIT_V(0);
    PG8_BAR;
#undef PG8_RSPF
#undef PG8_SA
#undef PG8_SB
#undef PG8_STAGE
#undef PG8_LDA
#undef PG8_LDB
#undef PG8_MMA
#undef PG8_WAIT_V
#undef PG8_WAIT_L
#undef PG8_BAR
#undef PG8_SCHED
}
}
using pg8::Unit;
typedef f32x4 Acc[2][2][4][2];

struct EpiSwiGLU { static constexpr bool MIDK = false; static constexpr bool RSPF = true; static constexpr bool PERM = true; bf16_t* H; const float* ssq; const LAS unsigned char* lds;
    __device__ __forceinline__ void operator()(const Acc& acc, const Unit& u, int wr, int wc, int fr, int fq, const float (&rsv)[2][4]) const {
        const int row0 = u.pm * 256 + wr * 64 + fr; const int hc = u.pn * 128 + wc * 32 + 8 * fq;
#pragma unroll
        for (int ai = 0; ai < 2; ++ai)
#pragma unroll
            for (int m = 0; m < 4; ++m) { const size_t row = (size_t)(row0 + ai * 128 + m * 16); const float rs = rsv[ai][m];
                const float c1 = rs * -1.4426950408889634f, c2 = rs * rs;
                f32x4 h[2];
#pragma unroll
                for (int n = 0; n < 2; ++n)
#pragma unroll
                    for (int p = 0; p < 2; ++p) { const f32x2v g = (f32x2v){acc[ai][0][m][n][2 * p], acc[ai][0][m][n][2 * p + 1]}, uu = (f32x2v){acc[ai][1][m][n][2 * p], acc[ai][1][m][n][2 * p + 1]};
                        const f32x2v a = g * c1; f32x2v d = (f32x2v){__builtin_amdgcn_exp2f(a.x), __builtin_amdgcn_exp2f(a.y)}; d = d + 1.0f;
                        const f32x2v t = (f32x2v){__builtin_amdgcn_rcpf(d.x), __builtin_amdgcn_rcpf(d.y)}; const f32x2v hv = ((g * uu) * c2) * t;
                        h[n][2 * p] = hv.x; h[n][2 * p + 1] = hv.y; }
                *(u32x4*)(H + row * DFF + hc) = pack8(h[0], h[1]); }
    }
};
struct EpiResid { static constexpr bool MIDK = false; static constexpr bool RSPF = false; static constexpr bool PERM = true; bf16_t* xb; float* ssq; float* outf; float scale;
    __device__ __forceinline__ void operator()(const Acc& acc, const Unit& u, int wr, int wc, int fr, int fq) const {
        const int row0 = u.pm * 256 + wr * 64 + fr; const int c8 = u.pn * 256 + wc * 32 + 8 * fq;
#pragma unroll
        for (int ai = 0; ai < 2; ++ai) { u32x4 bv[4][2];
#pragma unroll
            for (int m = 0; m < 4; ++m)
#pragma unroll
                for (int bj = 0; bj < 2; ++bj) bv[m][bj] = *(const u32x4*)(xb + (size_t)(row0 + ai * 128 + m * 16) * DM + c8 + bj * 128);
#pragma unroll
            for (int m = 0; m < 4; ++m) { const size_t row = (size_t)(row0 + ai * 128 + m * 16); float s = 0.f;
#pragma unroll
                for (int bj = 0; bj < 2; ++bj) { const size_t off = row * DM + c8 + bj * 128; f32x4 b0, b1; unpack8(bv[m][bj], b0, b1);
                    const f32x4 o0 = b0 + acc[ai][bj][m][0] * scale, o1 = b1 + acc[ai][bj][m][1] * scale;
                    if (outf) { *(f32x4*)(outf + off) = o0; *(f32x4*)(outf + off + 4) = o1; }
                    if (!outf) *(u32x4*)(xb + off) = pack8(o0, o1);
                    s += ((o0[0] * o0[0] + o0[1] * o0[1]) + (o0[2] * o0[2] + o0[3] * o0[3])) + ((o1[0] * o1[0] + o1[1] * o1[1]) + (o1[2] * o1[2] + o1[3] * o1[3])); }
                s += __shfl_xor(s, 16); s += __shfl_xor(s, 32);
                if (fq == 0 && !outf) ssq[row * 16 + u.pn * 4 + wc] = s; }
            asm volatile("" ::: "memory"); }
    }
};
struct EpiWin { static constexpr bool MIDK = false; static constexpr bool RSPF = true; static constexpr bool PERM = true; bf16_t* qkv; bf16_t* gr; bf16_t* gf; const float* ssq; const LAS unsigned char* lds;
    __device__ __forceinline__ void operator()(const Acc& acc, const Unit& u, int wr, int wc, int fr, int fq, const float (&rsv)[2][4]) const {
        const int row0 = u.pm * 256 + wr * 64 + fr; const int c8 = wc * 32 + 8 * fq;
        const bool gate = u.pn >= 3;
#pragma unroll
        for (int ai = 0; ai < 2; ++ai)
#pragma unroll
            for (int m = 0; m < 4; ++m) { const size_t row = (size_t)(row0 + ai * 128 + m * 16); const float rs = rsv[ai][m];
                if (!gate) {
#pragma unroll
                    for (int bj = 0; bj < 2; ++bj) *(u32x4*)(qkv + row * 768 + u.pn * 256 + bj * 128 + c8) = pack8(acc[ai][bj][m][0] * rs, acc[ai][bj][m][1] * rs);
                } else { const float c1 = rs * -1.4426950408889634f; f32x4 r0, r1, g0, g1;
#pragma unroll
                    for (int n = 0; n < 2; ++n)
#pragma unroll
                        for (int p = 0; p < 2; ++p) { const f32x2v xa = (f32x2v){acc[ai][0][m][n][2 * p], acc[ai][0][m][n][2 * p + 1]} * c1, xf = (f32x2v){acc[ai][1][m][n][2 * p], acc[ai][1][m][n][2 * p + 1]} * c1;
                            const f32x2v da = (f32x2v){__builtin_amdgcn_exp2f(xa.x), __builtin_amdgcn_exp2f(xa.y)} + 1.0f;
                            const f32x2v df = (f32x2v){fminf(__builtin_amdgcn_exp2f(xf.x), 1e30f), fminf(__builtin_amdgcn_exp2f(xf.y), 1e30f)} + 1.0f;
                            const f32x2v sa = (f32x2v){__builtin_amdgcn_rcpf(da.x), __builtin_amdgcn_rcpf(da.y)}, sf = (f32x2v){__builtin_amdgcn_rcpf(df.x), __builtin_amdgcn_rcpf(df.y)};
                            const f32x2v rr = df * sa;
                            if (n == 0) { r0[2 * p] = rr.x; r0[2 * p + 1] = rr.y; g0[2 * p] = sf.x; g0[2 * p + 1] = sf.y; } else { r1[2 * p] = rr.x; r1[2 * p + 1] = rr.y; g1[2 * p] = sf.x; g1[2 * p + 1] = sf.y; } }
                    const size_t off = row * DM + (u.pn - 3) * 128 + c8;
                    *(u32x4*)(gr + off) = pack8(r0, r1); *(u32x4*)(gf + off) = pack8(g0, g1); } }
    }
};
struct EpiPQ { static constexpr bool MIDK = false; static constexpr bool RSPF = false; static constexpr bool PERM = true; bf16_t* d0; const float* ssq; int N1, S;
    __device__ __forceinline__ void operator()(const Acc& acc, const Unit& u, int wr, int wc, int fr, int fq) const {
        const int hp = N1 >> 1; const int b = u.pn / hp, sp = u.pn % hp; const int s2b = wc * 32 + 8 * fq;
        const float myrs = row_rs(ssq, (size_t)(b * S + 2 * sp + (fr >> 3) + N1 * (s2b + (fr & 7))));
        float rsv[2][8];
#pragma unroll
        for (int bj = 0; bj < 2; ++bj)
#pragma unroll
            for (int e = 0; e < 8; ++e) rsv[bj][e] = __shfl(myrs, (fq << 4) | (bj * 8 + e));
        asm volatile("" ::: "memory");
#pragma unroll
        for (int ai = 0; ai < 2; ++ai)
#pragma unroll
            for (int m = 0; m < 4; ++m) { const int chn = u.pm * 256 + ai * 128 + wr * 64 + m * 16 + fr; const int part = chn >> 9, c = chn & 511;
#pragma unroll
                for (int bj = 0; bj < 2; ++bj) { f32x4 v0 = acc[ai][bj][m][0], v1 = acc[ai][bj][m][1];
#pragma unroll
                    for (int i = 0; i < 4; ++i) { v0[i] *= rsv[bj][i]; v1[i] *= rsv[bj][4 + i]; }
                    const size_t idx = ((size_t)(b * 512 + c) * N1 + (2 * sp + bj)) * 256 + part * 128 + s2b;
                    *(u32x4*)(d0 + idx) = pack8(v0, v1); } asm volatile("" ::: "memory"); }
    }
};
struct EpiDft1 { static constexpr bool MIDK = false; static constexpr bool RSPF = false; static constexpr bool PERM = true; bf16_t* t1p; int N1, lgN1, S; float invS;
    __device__ __forceinline__ void operator()(const Acc& acc, const Unit& u, int wr, int wc, int fr, int fq) const {
#pragma unroll
        for (int m = 0; m < 4; ++m) { const int k2 = wr * 64 + m * 16 + fr; const float dl = (float)k2 * invS;
#pragma unroll
            for (int bj = 0; bj < 2; ++bj) { const int j0 = u.pn * 256 + bj * 128 + wc * 32 + 8 * fq; const int s10 = j0 & (N1 - 1); const int bc = j0 >> lgN1;
                const float ph0 = (float)((s10 * k2) & (S - 1)) * invS;
                const size_t idx = (((size_t)bc * 128 + k2) * 2) * N1 + s10;
                u32x4 wu, wv;
#pragma unroll
                for (int n = 0; n < 2; ++n) { float uo[4], vo[4];
#pragma unroll
                    for (int i = 0; i < 4; ++i) { const float ph = ph0 + (float)(4 * n + i) * dl;
                        const float cs = cos_rev(ph), sn = sin_rev(ph); const float U = acc[0][bj][m][n][i], V = acc[1][bj][m][n][i];
                        uo[i] = cs * U - sn * V; vo[i] = sn * U + cs * V; }
                    const unsigned u0 = cvt_pk_bf16(uo[0], uo[1]), u1 = cvt_pk_bf16(uo[2], uo[3]), v0 = cvt_pk_bf16(vo[0], vo[1]), v1 = cvt_pk_bf16(vo[2], vo[3]);
                    if (n == 0) { wu.x = u0; wu.y = u1; wv.x = v0; wv.y = v1; } else { wu.z = u0; wu.w = u1; wv.z = v0; wv.w = v1; } }
                *(u32x4*)(t1p + idx) = wu; *(u32x4*)(t1p + idx + N1) = wv; asm volatile("" ::: "memory"); } }
    }
};
struct EpiDft2 { static constexpr bool MIDK = false; static constexpr bool RSPF = false; static constexpr bool PERM = true; bf16_t* fo; int N1, lgN1, S;
    __device__ __forceinline__ void operator()(const Acc& acc, const Unit& u, int wr, int wc, int fr, int fq) const {
        const int ng = N1 >> 1; const int chalf = u.pn & 1, k2g = (u.pn >> 1) % ng, b = (u.pn >> 1) / ng; const int kper = 256 >> lgN1;
#pragma unroll
        for (int ai = 0; ai < 2; ++ai)
#pragma unroll
            for (int m = 0; m < 4; ++m) { const int r = ai * 128 + wr * 64 + m * 16 + fr; const int k2s = r >> lgN1, k1 = r & (N1 - 1);
                const size_t tok = (size_t)b * S + 128 * k1 + k2g * kper + k2s;
#pragma unroll
                for (int bj = 0; bj < 2; ++bj) *(u32x4*)(fo + tok * 1024 + 512 + chalf * 256 + bj * 128 + wc * 32 + 8 * fq) = pack8(acc[ai][bj][m][0], acc[ai][bj][m][1]); }
    }
};
struct EpiBr { static constexpr bool MIDK = true; static constexpr bool RSPF = false; static constexpr bool PERM = true; const bf16_t* gr; const bf16_t* gf; bf16_t* gated;
    __device__ __forceinline__ void mid(Acc& acc, const Unit& u, int wr, int wc, int fr, int fq) const {
        const int row0 = u.pm * 256 + wr * 64 + fr; const int c8 = u.pn * 256 + wc * 32 + 8 * fq;
        u32x4 rv[2][4][2];
#pragma unroll
        for (int ai = 0; ai < 2; ++ai)
#pragma unroll
            for (int m = 0; m < 4; ++m)
#pragma unroll
                for (int bj = 0; bj < 2; ++bj) rv[ai][m][bj] = *(const u32x4*)(gr + (size_t)(row0 + ai * 128 + m * 16) * DM + c8 + bj * 128);
#pragma unroll
        for (int ai = 0; ai < 2; ++ai)
#pragma unroll
            for (int m = 0; m < 4; ++m)
#pragma unroll
                for (int bj = 0; bj < 2; ++bj) { f32x4 a0, a1; unpack8(rv[ai][m][bj], a0, a1); acc[ai][bj][m][0] *= a0; acc[ai][bj][m][1] *= a1; }
    }
    __device__ __forceinline__ void operator()(const Acc& acc, const Unit& u, int wr, int wc, int fr, int fq) const {
        const int row0 = u.pm * 256 + wr * 64 + fr; const int c8 = u.pn * 256 + wc * 32 + 8 * fq;
        u32x4 fv[2][4][2];
#pragma unroll
        for (int ai = 0; ai < 2; ++ai)
#pragma unroll
            for (int m = 0; m < 4; ++m)
#pragma unroll
                for (int bj = 0; bj < 2; ++bj) fv[ai][m][bj] = *(const u32x4*)(gf + (size_t)(row0 + ai * 128 + m * 16) * DM + c8 + bj * 128);
#pragma unroll
        for (int ai = 0; ai < 2; ++ai)
#pragma unroll
            for (int m = 0; m < 4; ++m)
#pragma unroll
                for (int bj = 0; bj < 2; ++bj) { const size_t off = (size_t)(row0 + ai * 128 + m * 16) * DM + c8 + bj * 128; f32x4 g0, g1; unpack8(fv[ai][m][bj], g0, g1);
                    *(u32x4*)(gated + off) = pack8(g0 * acc[ai][bj][m][0], g1 * acc[ai][bj][m][1]); }
    }
};

struct OrderPQ {
    int G, c, N1, S;
    __device__ bool next(int i, Unit& u) const { const int L = i * G + c; if (L >= 4 * 128) return false; u.pm = L & 3; u.pn = L >> 2;
        const int hp = N1 >> 1; const int b = u.pn / hp, sp = u.pn % hp; u.offA = (size_t)u.pm * 256 * 1024 * 2; u.offB = ((size_t)b * S + 2 * sp) * 1024 * 2; return true; }
};
struct OrderWin {
    int G, vcu, lo, hi;
    __device__ bool next(int i, Unit& u) const { const int v = lo + vcu + G * i; if (v >= hi) return false;
        if (v < 384) { u.pm = (v * 21846) >> 16; u.pn = v - 3 * u.pm; } else { const int w = v - 384; u.pm = w >> 3; u.pn = 3 + (w & 7); }
        u.offA = (size_t)u.pm * 256 * 1024 * 2; u.offB = (size_t)u.pn * 256 * 1024 * 2; return true; }
};
struct OrderD1b {
    int G, c, vcu;
    __device__ bool next(int i, Unit& u) const { int L;
        if (G == 256) { if (vcu < 128) { if (i >= 1) return false; L = vcu; } else { if (i >= 3) return false; L = 128 + (vcu - 128) * 3 + i; } }
        else { L = i * G + c; if (L >= 512) return false; }
        u.pm = 0; u.pn = L; u.offA = 0; u.offB = (size_t)L * 256 * 256 * 2; return true; }
};
struct OrderD1 {
    int G, c;
    __device__ bool next(int i, Unit& u) const { const int L = i * G + c; if (L >= 512) return false; u.pm = 0; u.pn = L; u.offA = 0; u.offB = (size_t)L * 256 * 256 * 2; return true; }
};
struct OrderD2 {
    int G, c, N1;
    __device__ bool next(int i, Unit& u) const { const int L = i * G + c; if (L >= 256) return false; u.pm = 0; u.pn = L; const int ng = N1 >> 1;
        const int chalf = L & 1, k2g = (L >> 1) % ng, b = (L >> 1) / ng; u.offA = 0; u.offB = (((size_t)b * 512 + chalf * 256) * (256 * (size_t)N1) + (size_t)k2g * 512) * 2; return true; }
};

constexpr int KP = 72, VP = 408;
__device__ __forceinline__ void attn_unit(LAS unsigned char* lds, const bf16_t* qkv, bf16_t* ao, const float* qg, const float* kg, const float* sink, int b, int nb, int kvh, int S) {
    int tid_ = threadIdx.x; asm volatile("" : "+v"(tid_));
    const int tid = tid_, lane = tid & 63, wid = __builtin_amdgcn_readfirstlane(tid >> 6), fr = lane & 15, fq = lane >> 4;
    LAS bf16_t* Ks = (LAS bf16_t*)lds;
    LAS bf16_t* Vt = (LAS bf16_t*)(lds + 384 * KP * 2);
    for (int i = tid; i < 64 * 24; i += 512) { const int d = i / 24, cc = 384 + i % 24; Vt[d * VP + cc] = 0; }
#pragma unroll 1
    for (int it = 0; it < 6; ++it) { const int i = tid + 512 * it; const int key = i >> 3, ch = i & 7; const int s = nb * 128 - 128 + key; const bool ok = (s >= 0 && s < S);
        u32x4 kw = (u32x4){0u, 0u, 0u, 0u}, vw = (u32x4){0u, 0u, 0u, 0u};
        if (ok) { const bf16_t* p = qkv + ((size_t)b * S + s) * 768 + 512 + kvh * 64 + ch * 8; kw = *(const u32x4*)p; vw = *(const u32x4*)(p + 128); }
        f32x4 k0, k1; unpack8(kw, k0, k1);
        float ss = (k0[0] * k0[0] + k0[1] * k0[1]) + (k0[2] * k0[2] + k0[3] * k0[3]) + (k1[0] * k1[0] + k1[1] * k1[1]) + (k1[2] * k1[2] + k1[3] * k1[3]);
        ss += __shfl_xor(ss, 1); ss += __shfl_xor(ss, 2); ss += __shfl_xor(ss, 4);
        const float rk = rsqrtf(ss * (1.0f / 64.0f) + EPS);
        const f32x4 g0 = *(const f32x4*)(kg + ch * 8), g1 = *(const f32x4*)(kg + ch * 8 + 4);
        *(LAS u32x4*)(Ks + key * KP + ch * 8) = pack8(k0 * g0 * rk, k1 * g1 * rk);
        const unsigned vv[4] = {vw.x, vw.y, vw.z, vw.w};
#pragma unroll
        for (int e = 0; e < 4; ++e) { Vt[(ch * 8 + 2 * e) * VP + key] = (bf16_t)(vv[e] & 0xffffu); Vt[(ch * 8 + 2 * e + 1) * VP + key] = (bf16_t)(vv[e] >> 16); }
    }
    __syncthreads();
    const int g = wid >> 1, qh = wid & 1, h = kvh * 4 + g;
    constexpr float LOG2E = 1.4426950408889634f; const int nblk = S >> 7;
    const float sl = exp2f(-(float)(h + 1)) * LOG2E; const float snk2 = sink[h] * LOG2E;
    const f32x4 qg0 = *(const f32x4*)(qg + fq * 8), qg1 = *(const f32x4*)(qg + fq * 8 + 4), qg2 = *(const f32x4*)(qg + 32 + fq * 8), qg3 = *(const f32x4*)(qg + 32 + fq * 8 + 4);
#pragma unroll 1
    for (int i4 = 0; i4 < 4; ++i4) { const int qt = qh * 4 + i4; const int q0 = qt * 16;
        const size_t tok = (size_t)b * S + nb * 128 + q0 + fr;
        const bf16_t* qp = qkv + tok * 768 + h * 64 + fq * 8;
        f32x4 a0, a1, a2, a3; unpack8(*(const u32x4*)qp, a0, a1); unpack8(*(const u32x4*)(qp + 32), a2, a3);
        float ss = 0.f;
#pragma unroll
        for (int i = 0; i < 4; ++i) ss += a0[i] * a0[i] + a1[i] * a1[i] + a2[i] * a2[i] + a3[i] * a3[i];
        ss += __shfl_xor(ss, 16); ss += __shfl_xor(ss, 32);
        const float rq = rsqrtf(ss * (1.0f / 64.0f) + EPS) * 0.125f;
        const bf16x8 qa0 = __builtin_bit_cast(bf16x8, pack8(a0 * qg0 * rq, a1 * qg1 * rq)), qa1 = __builtin_bit_cast(bf16x8, pack8(a2 * qg2 * rq, a3 * qg3 * rq));
        f32x4 st[17];
#pragma unroll
        for (int t = 0; t < 17; ++t) { const LAS bf16_t* kp = Ks + (16 * (qt + t) + fr) * KP + fq * 8;
            const bf16x8 kf0 = *(const LAS bf16x8*)kp, kf1 = *(const LAS bf16x8*)(kp + 32);
            f32x4 z = (f32x4){0.f, 0.f, 0.f, 0.f};
            z = __builtin_amdgcn_mfma_f32_16x16x32_bf16(kf0, qa0, z, 0, 0, 0);
            st[t] = __builtin_amdgcn_mfma_f32_16x16x32_bf16(kf1, qa1, z, 0, 0, 0); }
        const int c = fr - 4 * fq; const float A1 = -sl * (float)c;
        float mx = -1e30f;
#pragma unroll
        for (int t = 0; t < 17; ++t)
#pragma unroll
            for (int jj = 0; jj < 4; ++jj) { float bias;
                if (t < 8) bias = __builtin_fmaf(-sl, (float)(128 - 16 * t - jj), A1);
                else if (t > 8) bias = __builtin_fmaf(-sl, (float)(16 * t + jj - 128), -A1);
                else { const int d = c - jj; bias = -sl * (float)(d < 0 ? -d : d); }
                float v = __builtin_fmaf(st[t][jj], LOG2E, bias);
                if (t == 0) v = (c > jj) ? -1e30f : v;
                if (t == 16) v = (jj > c) ? -1e30f : v;
                st[t][jj] = v; }
        if (nb == 0) { const int e0 = q0 + 4 * fq;
#pragma unroll
            for (int t = 0; t < 8; ++t)
#pragma unroll
                for (int jj = 0; jj < 4; ++jj) st[t][jj] = (e0 + jj < 128 - 16 * t) ? -1e30f : st[t][jj]; }
        if (nb == nblk - 1) { const int e0 = q0 + 4 * fq;
#pragma unroll
            for (int t = 9; t < 17; ++t)
#pragma unroll
                for (int jj = 0; jj < 4; ++jj) st[t][jj] = (e0 + jj >= 256 - 16 * t) ? -1e30f : st[t][jj]; }
#pragma unroll
        for (int t = 0; t < 17; ++t) mx = fmaxf(fmaxf(mx, fmaxf(st[t][0], st[t][1])), fmaxf(st[t][2], st[t][3]));
        mx = fmaxf(mx, __shfl_xor(mx, 16)); mx = fmaxf(mx, __shfl_xor(mx, 32)); mx = fmaxf(mx, snk2);
        float sum = 0.f;
#pragma unroll
        for (int t = 0; t < 17; ++t)
#pragma unroll
            for (int jj = 0; jj < 4; ++jj) { const float p = __builtin_amdgcn_exp2f(st[t][jj] - mx); st[t][jj] = p; sum += p; }
        sum += __shfl_xor(sum, 16); sum += __shfl_xor(sum, 32); sum += __builtin_amdgcn_exp2f(snk2 - mx);
        const float inv = 1.0f / sum;
        f32x4 o[4];
#pragma unroll
        for (int dt = 0; dt < 4; ++dt) o[dt] = (f32x4){0.f, 0.f, 0.f, 0.f};
#pragma unroll
        for (int uu = 0; uu < 9; ++uu) { const f32x4 zero4 = (f32x4){0.f, 0.f, 0.f, 0.f};
            const bf16x8 pb = __builtin_bit_cast(bf16x8, pack8(st[2 * uu], (2 * uu + 1 < 17) ? st[(2 * uu + 1 < 17) ? 2 * uu + 1 : 16] : zero4));
#pragma unroll
            for (int dt = 0; dt < 4; ++dt) { const LAS bf16_t* vp = Vt + (16 * dt + fr) * VP + 16 * (qt + 2 * uu) + 4 * fq;
                const u32x2 lo = *(const LAS u32x2*)vp, hi = *(const LAS u32x2*)(vp + 16);
                const bf16x8 va = __builtin_bit_cast(bf16x8, (u32x4){lo.x, lo.y, hi.x, hi.y});
                o[dt] = __builtin_amdgcn_mfma_f32_16x16x32_bf16(va, pb, o[dt], 0, 0, 0); } }
        bf16_t* op = ao + tok * 1024 + h * 64 + 4 * fq;
#pragma unroll
        for (int dt = 0; dt < 4; ++dt) { u32x2 w; w.x = cvt_pk_bf16(o[dt][0] * inv, o[dt][1] * inv); w.y = cvt_pk_bf16(o[dt][2] * inv, o[dt][3] * inv); *(u32x2*)(op + 16 * dt) = w; }
    }
    __syncthreads();
}

__device__ __forceinline__ void tr_item(const float* W, int ldw, int K, int k0, int src0, int dst0, bf16_t* WT, const float* gain, LAS float* scr, int lane, int kd = 0) {
    { f32x4 v[8]; const int c4 = (lane & 7) * 4;
#pragma unroll
      for (int i = 0; i < 8; ++i) v[i] = *(const f32x4*)(W + (size_t)(k0 + 8 * i + (lane >> 3)) * ldw + src0 + c4);
#pragma unroll
      for (int i = 0; i < 8; ++i) { const int kk = 8 * i + (lane >> 3); const float gk = gain ? gain[k0 + kk] : 1.0f;
#pragma unroll
          for (int j = 0; j < 4; ++j) scr[kk * 33 + c4 + j] = v[i][j] * gk; } }
    asm volatile("s_waitcnt lgkmcnt(0)" ::: "memory");
    const int c = lane & 7;
#pragma unroll
    for (int j = 0; j < 4; ++j) { const int n = (lane >> 3) + 8 * j; const LAS float* s = scr + (8 * c) * 33 + n;
        u32x4 o; o.x = cvt_pk_bf16(s[0 * 33], s[1 * 33]); o.y = cvt_pk_bf16(s[2 * 33], s[3 * 33]); o.z = cvt_pk_bf16(s[4 * 33], s[5 * 33]); o.w = cvt_pk_bf16(s[6 * 33], s[7 * 33]);
        *(u32x4*)(WT + (size_t)(dst0 + n) * K + kd + k0 + 8 * c) = o; }
    asm volatile("s_waitcnt lgkmcnt(0)" ::: "memory");
}

struct Args {
    const float* xin[2]; const float* ln_ffn1; const float* w_ffn1_in; const float* w_ffn1_out; const float* ln_mix; const float* w_in;
    const float* q_gain; const float* k_gain; const float* sink; const float* w_attn_br; const float* w_four_br; const float* w_out;
    const float* ln_ffn2; const float* w_ffn2_in; const float* w_ffn2_out; float* out; unsigned char* ws;
};

__device__ __forceinline__ void convert_layer(const Args& a, int l, LAS unsigned char* lds, int G) {
    int tid_ = threadIdx.x; asm volatile("" : "+v"(tid_));
    const int tid = tid_, lane = tid & 63, wid = __builtin_amdgcn_readfirstlane(tid >> 6);
    LAS float* scr = (LAS float*)(lds + wid * 16384);
    LAS float* tab = (LAS float*)(lds + LDS_TAB);
    if (tid < 128) { tab[tid] = cos_rev((float)tid * (1.0f / 128.0f)); tab[128 + tid] = sin_rev((float)tid * (1.0f / 128.0f)); }
    __syncthreads();
    unsigned char* wt = a.ws + WS_WT;
    const int gw = blockIdx.x * 8 + wid, NGW = G * 8;
    constexpr int I0 = 16 * 176, I1 = 44 * 32, I2 = 16 * 88, I3 = 8 * 32, I4 = 8 * 32, I5 = 16 * 32, I6 = I0, I7 = I1;
    constexpr int NTR = I0 + I1 + I2 + I3 + I4 + I5 + I6 + I7;
    for (int it = gw; it < NTR; it += NGW) {
        int r = it;
        if (r < I0 || (r >= I0 + I1 + I2 + I3 + I4 + I5 && r < NTR - I7)) {
            const bool second = r >= I0; if (second) r -= I0 + I1 + I2 + I3 + I4 + I5;
            const float* W = (second ? a.w_ffn2_in : a.w_ffn1_in) + (size_t)l * DM * 2 * DFF; const float* gn = (second ? a.ln_ffn2 : a.ln_ffn1) + l * DM;
            const int kb = r / 176, nb = r % 176; const int n0 = nb * 32; const int t = n0 >> 8, hh = (n0 >> 7) & 1, i0 = n0 & 127;
            tr_item(W, 2 * DFF, DM, kb * 64, hh * DFF + 128 * t + i0, n0, (bf16_t*)(wt + (second ? WT_FFN_IN1 : WT_FFN_IN0)), gn, scr, lane); continue; }
        r -= I0;
        if (r < I1) { const int kb = r / 32, nb = r % 32; tr_item(a.w_ffn1_out + (size_t)l * DFF * DM, DM, DFF, kb * 64, nb * 32, nb * 32, (bf16_t*)(wt + WT_FFN_OUT0), nullptr, scr, lane); continue; }
        r -= I1;
        if (r < I2) { const int kb = r / 88, nb = r % 88; const int n0 = nb * 32; tr_item(a.w_in + (size_t)l * DM * WIN_COLS, WIN_COLS, DM, kb * 64, n0 < 768 ? n0 : 1280 + (((n0 - 768) >> 7) & 1) * 1024 + ((n0 - 768) >> 8) * 128 + ((n0 - 768) & 127), n0, (bf16_t*)(wt + WT_WIN), a.ln_mix + l * DM, scr, lane); continue; }
        r -= I2;
        if (r < I3) { const int kb = r / 32, nb = r % 32; tr_item(a.w_attn_br + (size_t)l * 512 * DM, DM, 1024, kb * 64, nb * 32, nb * 32, (bf16_t*)(wt + WT_ABR), nullptr, scr, lane, 0); continue; }
        r -= I3;
        if (r < I4) { const int kb = r / 32, nb = r % 32; tr_item(a.w_four_br + (size_t)l * 512 * DM, DM, 1024, kb * 64, nb * 32, nb * 32, (bf16_t*)(wt + WT_ABR), nullptr, scr, lane, 512); continue; }
        r -= I4;
        if (r < I5) { const int kb = r / 32, nb = r % 32; tr_item(a.w_out + (size_t)l * DM * DM, DM, DM, kb * 64, nb * 32, nb * 32, (bf16_t*)(wt + WT_WOUT), nullptr, scr, lane); continue; }
        r -= I5 + I6;
        { const int kb = r / 32, nb = r % 32; tr_item(a.w_ffn2_out + (size_t)l * DFF * DM, DM, DFF, kb * 64, nb * 32, nb * 32, (bf16_t*)(wt + WT_FFN_OUT1), nullptr, scr, lane); }
    }
    bf16_t* pq = (bf16_t*)(wt + WT_PQ); const float* Wl = a.w_in + (size_t)l * DM * WIN_COLS; const float* gm = a.ln_mix + l * DM;
    for (int it = gw; it < DM * 4; it += NGW) { const int k = it >> 2, grp = it & 3;
        const float* wrow = Wl + (size_t)k * WIN_COLS + 768 + grp * 128; const float w0 = wrow[lane], w1 = wrow[64 + lane];
        float pc0 = 0.f, ps0 = 0.f, pc1 = 0.f, ps1 = 0.f;
        for (int c = 0; c < 128; ++c) { const float w = __shfl(c < 64 ? w0 : w1, c & 63); const int j0 = (c * lane) & 127, j1 = (c * (lane + 64)) & 127;
            pc0 += w * tab[j0]; ps0 += w * tab[128 + j0]; pc1 += w * tab[j1]; ps1 += w * tab[128 + j1]; }
        const float gk = gm[k];
        pq[(size_t)(grp * 128 + lane) * DM + k] = (bf16_t)f2bf(pc0 * gk); pq[(size_t)(grp * 128 + 64 + lane) * DM + k] = (bf16_t)f2bf(pc1 * gk);
        pq[(size_t)(512 + grp * 128 + lane) * DM + k] = (bf16_t)f2bf(ps0 * gk); pq[(size_t)(512 + grp * 128 + 64 + lane) * DM + k] = (bf16_t)f2bf(ps1 * gk); }
}

__device__ __forceinline__ void init_phase(const Args& a, int G, int row_lo, int row_hi, bool consts) {
    int tid_ = threadIdx.x; asm volatile("" : "+v"(tid_));
    const int tid = tid_, lane = tid & 63, wid = tid >> 6;
    const int gt = blockIdx.x * 512 + tid, NT = G * 512;
    if (consts) {
    bf16_t* W1 = (bf16_t*)(a.ws + WS_W1);
    for (int i = gt; i < 65536; i += NT) { const int r = i >> 8, col = i & 255; const int po = r >> 7, k2 = r & 127, pi = col >> 7, s2 = col & 127;
        const float ph = (float)((s2 * k2) & 127) * (1.0f / 128.0f); const float cs = cos_rev(ph), sn = sin_rev(ph);
        W1[i] = (bf16_t)f2bf(po == pi ? cs : (po == 0 ? -sn : sn)); }
#pragma unroll
    for (int v = 0; v < 2; ++v) { const int lg = 5 + v, N1 = 1 << lg; bf16_t* W2 = (bf16_t*)(a.ws + (v ? WS_W2B : WS_W2A)); const float norm = rsqrtf(128.0f * 128.0f * (float)N1);
        for (int i = gt; i < 131072; i += NT) { const int r = i >> 9, kk = i & 511; const int k2s = r >> lg, k1 = r & (N1 - 1), k2sp = kk >> (lg + 1), part = (kk >> lg) & 1, s1 = kk & (N1 - 1);
            float val = 0.f; if (k2s == k2sp) { const float ph = (float)((s1 * k1) & (N1 - 1)) / (float)N1; val = norm * (part == 0 ? cos_rev(ph) : -sin_rev(ph)); }
            W2[i] = (bf16_t)f2bf(val); } }
    }
    bf16_t* XB = (bf16_t*)(a.ws + WS_XB); float* ssq = (float*)(a.ws + WS_SSQ);
    const int gw = blockIdx.x * 8 + wid, NGW = G * 8;
    for (int m = row_lo + gw; m < row_hi; m += NGW) { const float* xr = (m < MH) ? a.xin[0] + (size_t)m * DM : a.xin[1] + (size_t)(m - MH) * DM;
        f32x4 v[4]; float s = 0.f;
#pragma unroll
        for (int j = 0; j < 4; ++j) { v[j] = ((const f32x4*)xr)[lane + 64 * j]; s += (v[j][0] * v[j][0] + v[j][1] * v[j][1]) + (v[j][2] * v[j][2] + v[j][3] * v[j][3]); }
        s = wave_sum(s);
#pragma unroll
        for (int j = 0; j < 4; ++j) { u32x2 w; w.x = cvt_pk_bf16(v[j][0], v[j][1]); w.y = cvt_pk_bf16(v[j][2], v[j][3]); ((u32x2*)(XB + (size_t)m * DM))[lane + 64 * j] = w; }
        if (lane < 16) ssq[(size_t)m * 16 + lane] = (lane == 0) ? s : 0.f; }
}

#define XB_TMO      128
#define XB_XCNT(j)  (256  + 64 * (j))
#define XB_XSUB(j)  (1280 + 64 * (j))
#define XB_XGEN(j)  (2304 + 64 * (j))
#define XB_TOP      3328
#define XB_TOPGEN   3392
#define XCD_BAR_WORDS 3456
#define XB_SPIN_CAP (1u << 18)

__device__ __forceinline__ unsigned xb_ld(unsigned* p)              { return __hip_atomic_load(p, __ATOMIC_RELAXED, __HIP_MEMORY_SCOPE_AGENT); }
__device__ __forceinline__ unsigned xb_add(unsigned* p, unsigned v) { return __hip_atomic_fetch_add(p, v, __ATOMIC_RELAXED, __HIP_MEMORY_SCOPE_AGENT); }
__device__ __forceinline__ unsigned xb_xcc_id() { return (unsigned)__builtin_amdgcn_s_getreg((3 << 11) | 20) & 0xFu; }
#define XB_SPIN(cond, bar) do { unsigned _sp = 0; while (cond) { __builtin_amdgcn_s_sleep(1); \
    if ((++_sp & 255u) == 0u) { if (xb_ld(&(bar)[XB_TMO])) break; if (_sp > XB_SPIN_CAP) { atomicAdd(&(bar)[XB_TMO], 1u); break; } } } } while (0)

struct XcdBarrier {
    unsigned* bar; unsigned x;
    volatile LAS unsigned* st;
};

__device__ __forceinline__ XcdBarrier xcd_barrier_post(unsigned* bar, volatile LAS unsigned* st) {
    XcdBarrier b; b.bar = bar; b.x = xb_xcc_id(); b.st = st;
    if (threadIdx.x == 0) (void)xb_add(&bar[XB_XCNT(b.x)], 1u);
    return b;
}
__device__ __forceinline__ void xcd_barrier_complete(unsigned* bar, unsigned x, unsigned& nloc, unsigned& nx) {
    const unsigned G = gridDim.x * gridDim.y * gridDim.z;
    unsigned sum, cnt, mine, sp = 0u;
    for (;;) {
        sum = 0u; cnt = 0u; mine = 0u;
#pragma unroll
        for (unsigned j = 0; j < 16; ++j) { const unsigned c = xb_ld(&bar[XB_XCNT(j)]); sum += c; cnt += (c > 0u) ? 1u : 0u; mine = (j == x) ? c : mine; }
        if (sum == G) break;
        __builtin_amdgcn_s_sleep(1);
        if ((++sp & 255u) == 0u) { if (xb_ld(&bar[XB_TMO])) break; if (sp > XB_SPIN_CAP) { atomicAdd(&bar[XB_TMO], 1u); break; } }
    }
    nloc = mine > 0u ? mine : 1u; nx = cnt > 0u ? cnt : 1u;
}

__device__ __forceinline__ void xcd_barrier(const XcdBarrier& b) {
    asm volatile("s_waitcnt vmcnt(0)" ::: "memory");
    __syncthreads();
    if (threadIdx.x == 0) {
        unsigned* bar = b.bar;
        __builtin_amdgcn_s_waitcnt(0);
        unsigned nloc = b.st[0], nx = b.st[1];
        if (nloc == 0u) { xcd_barrier_complete(bar, b.x, nloc, nx); b.st[0] = nloc; b.st[1] = nx; }
        const unsigned old = xb_add(&bar[XB_XSUB(b.x)], 1u);
        const unsigned gen = old / nloc;
        if (old + 1u == (gen + 1u) * nloc) {
            __builtin_amdgcn_fence(__ATOMIC_RELEASE, "agent");
            asm volatile("s_waitcnt vmcnt(0)" ::: "memory");
            const unsigned og = xb_add(&bar[XB_TOP], 1u);
            const unsigned tg = og / nx;
            if (og + 1u == (tg + 1u) * nx) xb_add(&bar[XB_TOPGEN], 1u);
            else XB_SPIN(xb_ld(&bar[XB_TOPGEN]) == tg, bar);
            __builtin_amdgcn_fence(__ATOMIC_ACQUIRE, "agent");
            xb_add(&bar[XB_XGEN(b.x)], 1u);
            asm volatile("s_waitcnt vmcnt(0)" ::: "memory");
        } else {
            XB_SPIN(xb_ld(&bar[XB_XGEN(b.x)]) == gen, bar);
            __builtin_amdgcn_fence(__ATOMIC_ACQUIRE, "agent");
            asm volatile("s_waitcnt vmcnt(0)" ::: "memory");
        }
    }
    __syncthreads();
}


__global__ void __launch_bounds__(512, 2) mk_fwd(Args a) {
    extern __shared__ __attribute__((aligned(16))) unsigned char lds_raw[];
    LAS unsigned char* lds = (LAS unsigned char*)lds_raw;
    cg::grid_group grid = cg::this_grid();
    const int G = gridDim.x, cb = blockIdx.x; const int vcu = (G % 8 == 0) ? (cb % 8) * (G / 8) + cb / 8 : cb;
    unsigned char* ws = a.ws; unsigned char* wt = ws + WS_WT;
    volatile LAS unsigned* MISC = (volatile LAS unsigned*)(lds + LDS_MISC);
    if (threadIdx.x < 4) MISC[threadIdx.x] = 0u;
    __syncthreads();
    const XcdBarrier bar = xcd_barrier_post((unsigned*)(ws + WS_CTL), MISC);
    init_phase(a, G, 0, MH, true);
    convert_layer(a, 0, lds, G);
    grid.sync();
    for (int l = 0; l < DEPTH; ++l) {
        if (l > 0) { convert_layer(a, l, lds, G); xcd_barrier(bar); }
        for (int half = 0; half < 2; ++half) {
            const int S = half ? 8192 : 4096, N1 = half ? 64 : 32, lgN1 = half ? 6 : 5, NB = half ? 4 : 8;
            const size_t r0 = (size_t)half * MH;
            bf16_t* XBh = (bf16_t*)(ws + WS_XB) + r0 * DM; float* ssqh = (float*)(ws + WS_SSQ) + r0 * 16; float* outh = a.out + r0 * DM;
            unsigned char* R = ws + WS_R;
            for (int step = 0; step < 3; ++step) {
                if (step != 1) {
                    const int f = step >> 1;
                    { pg8::Gemm g{XBh, (const bf16_t*)(wt + (f ? WT_FFN_IN1 : WT_FFN_IN0)), DM, DM, (size_t)128 * DM * 2, (size_t)128 * DM * 2, DM};
                      pg8::StdOrder S_; S_.init(MH, 2 * DFF, G, cb, DM, DM);
                      EpiSwiGLU E{(bf16_t*)(R + R_H), ssqh, lds};
                      const bool cv = (l == 0 && half == 0 && step == 0); const bool cv_first = (cb & 7) < 4;
                      if (cv && cv_first) init_phase(a, G, MH, MT, false);
                      pg8::gemm_phase(lds, g, S_, E);
                      if (cv && !cv_first) init_phase(a, G, MH, MT, false); }
                    xcd_barrier(bar);
                    { pg8::Gemm g{(const bf16_t*)(R + R_H), (const bf16_t*)(wt + (f ? WT_FFN_OUT1 : WT_FFN_OUT0)), DFF, DFF, (size_t)128 * DFF * 2, (size_t)128 * DFF * 2, DFF};
                      pg8::StdOrder S_; S_.init(MH, DM, G, cb, DFF, DFF);
                      EpiResid E{XBh, ssqh, (l == DEPTH - 1 && step == 2) ? outh : nullptr, 0.5f};
                      pg8::gemm_phase(lds, g, S_, E); }
                    xcd_barrier(bar);
                } else {
                    bf16_t* QKV = (bf16_t*)(R + R_QKV); bf16_t* GA = (bf16_t*)(R + R_GA); bf16_t* GF = (bf16_t*)(R + R_GF);
                    bf16_t* D0 = (bf16_t*)(R + R_D0); bf16_t* T1P = (bf16_t*)(R + R_T1); bf16_t* AF = (bf16_t*)(R + R_AO); bf16_t* AO = AF; bf16_t* FO = AF;
                    { pg8::Gemm g{XBh, (const bf16_t*)(wt + WT_WIN), DM, DM, (size_t)128 * DM * 2, (size_t)128 * DM * 2, DM};
                      OrderWin S_{G, vcu, 0, 512};
                      EpiWin E{QKV, GA, GF, ssqh, lds};
                      pg8::gemm_phase(lds, g, S_, E); }
                    { pg8::Gemm g{(const bf16_t*)(wt + WT_PQ), XBh, DM, N1 * DM, (size_t)128 * DM * 2, (size_t)DM * 2, DM};
                      OrderPQ S_{G, vcu, N1, S};
                      EpiPQ E{D0, ssqh, N1, S};
                      pg8::gemm_phase(lds, g, S_, E); }
                    xcd_barrier(bar);
                    for (int pass = 0; pass < 2; ++pass) {
                        const bool gates_now = (pass == 0) == ((cb & 7) < 4);
                        if (gates_now) {
                            pg8::Gemm g{XBh, (const bf16_t*)(wt + WT_WIN), DM, DM, (size_t)128 * DM * 2, (size_t)128 * DM * 2, DM};
                            OrderWin S_{G, vcu, 512, 1408};
                            EpiWin E{QKV, GA, GF, ssqh, lds};
                            pg8::gemm_phase(lds, g, S_, E);
                        } else {
                            { const int nblk = S / 128; const float* qg = a.q_gain + l * 64; const float* kg = a.k_gain + l * 64; const float* sk = a.sink + l * NHEADS;
                              for (int u = vcu; u < NB * nblk * 2; u += G) { const int kvh = u & 1, bn = u >> 1; attn_unit(lds, QKV, AO, qg, kg, sk, bn / nblk, bn % nblk, kvh, S); } }
                            { pg8::Gemm g{(const bf16_t*)(ws + WS_W1), D0, 256, 256, (size_t)128 * 256 * 2, (size_t)128 * 256 * 2, 256};
                              OrderD1b S_{G, cb, vcu};
                              EpiDft1 E{T1P, N1, lgN1, S, 1.0f / (float)S};
                              pg8::gemm_phase(lds, g, S_, E); }
                        }
                    }
                    xcd_barrier(bar);
                    { pg8::Gemm g{(const bf16_t*)(ws + (half ? WS_W2B : WS_W2A)), T1P, 512, 256 * N1, (size_t)128 * 512 * 2, (size_t)128 * 256 * N1 * 2, 512};
                      OrderD2 S_{G, cb, N1};
                      EpiDft2 E{FO, N1, lgN1, S};
                      pg8::gemm_phase(lds, g, S_, E); }
                    xcd_barrier(bar);
                    { pg8::Gemm g{AF, (const bf16_t*)(wt + WT_ABR), DM, DM, (size_t)128 * DM * 2, (size_t)128 * DM * 2, DM};
                      pg8::StdOrder S_; S_.init(MH, DM, G, cb, DM, DM);
                      EpiBr E{GA, GF, T1P};
                      pg8::gemm_phase(lds, g, S_, E); }
                    xcd_barrier(bar);
                    { pg8::Gemm g{T1P, (const bf16_t*)(wt + WT_WOUT), DM, DM, (size_t)128 * DM * 2, (size_t)128 * DM * 2, DM};
                      pg8::StdOrder S_; S_.init(MH, DM, G, cb, DM, DM);
                      EpiResid E{XBh, ssqh, nullptr, 1.0f};
                      pg8::gemm_phase(lds, g, S_, E); }
                    xcd_barrier(bar);
                }
            }
        }
    }
}

extern "C" void kernel_launch(void* const* d_in, const int* in_sizes, int n_in, void* d_out, int out_size, void* d_ws, size_t ws_size, hipStream_t stream) {
    static int grid_blocks = 0;
    if (grid_blocks == 0) {
        if (n_in != 16 || out_size != MT * DM || ws_size < WS_END) { fprintf(stderr, "kernel_launch: unexpected shapes (n_in %d out %d ws %zu)\n", n_in, out_size, ws_size); grid_blocks = -1; return; }
        int dev = 0, cus = 0, per_cu = 0;
        hipGetDevice(&dev); hipDeviceGetAttribute(&cus, hipDeviceAttributeMultiprocessorCount, dev);
        hipFuncSetAttribute((const void*)mk_fwd, hipFuncAttributeMaxDynamicSharedMemorySize, LDS_BYTES);
        if (hipOccupancyMaxActiveBlocksPerMultiprocessor(&per_cu, (const void*)mk_fwd, 512, LDS_BYTES) != hipSuccess || per_cu < 1) per_cu = 1;
        (void)hipGetLastError();
        if (per_cu > 1) per_cu = 1;
        grid_blocks = cus * per_cu;
    }
    if (grid_blocks < 0) return;
    Args a{};
    a.xin[0] = (const float*)d_in[0]; a.xin[1] = (const float*)d_in[1]; a.ln_ffn1 = (const float*)d_in[2]; a.w_ffn1_in = (const float*)d_in[3]; a.w_ffn1_out = (const float*)d_in[4];
    a.ln_mix = (const float*)d_in[5]; a.w_in = (const float*)d_in[6]; a.q_gain = (const float*)d_in[7]; a.k_gain = (const float*)d_in[8]; a.sink = (const float*)d_in[9];
    a.w_attn_br = (const float*)d_in[10]; a.w_four_br = (const float*)d_in[11]; a.w_out = (const float*)d_in[12]; a.ln_ffn2 = (const float*)d_in[13];
    a.w_ffn2_in = (const float*)d_in[14]; a.w_ffn2_out = (const float*)d_in[15]; a.out = (float*)d_out; a.ws = (unsigned char*)d_ws;
    if (hipMemsetAsync((char*)d_ws + WS_CTL, 0, CTL_BYTES, stream) != hipSuccess) { fprintf(stderr, "kernel_launch: memset failed\n"); return; }
    void* args[] = {&a};
    hipError_t e = hipLaunchCooperativeKernel((const void*)mk_fwd, dim3(grid_blocks), dim3(512), args, LDS_BYTES, stream);
    if (e != hipSuccess) fprintf(stderr, "cooperative launch failed: %s (grid %d)\n", hipGetErrorString(e), grid_blocks);
}
```

```cpp
#include <hip/hip_runtime.h>
#include <hip/hip_cooperative_groups.h>
#include <cstdio>
#include <cstdint>
namespace cg = cooperative_groups;

#define LAS __attribute__((address_space(3)))
typedef unsigned short bf16_t;
typedef short bf16x8 __attribute__((ext_vector_type(8)));
typedef float f32x4 __attribute__((ext_vector_type(4)));
typedef unsigned u32x4 __attribute__((ext_vector_type(4)));
typedef unsigned u32x2 __attribute__((ext_vector_type(2)));
typedef float f32x2v __attribute__((ext_vector_type(2)));

constexpr int DM = 1024, DFF = 2816, NHEADS = 8, DEPTH = 4;
constexpr int MT = 65536, MH = 32768;
constexpr int WIN_COLS = 3328;
constexpr float EPS = 1e-6f;

constexpr size_t MiB = (size_t)1 << 20;
constexpr size_t WS_SSQ = 1 * MiB;
constexpr size_t WS_W1 = 5 * MiB;
constexpr size_t WS_W2A = WS_W1 + 128 * 1024;
constexpr size_t WS_W2B = WS_W2A + 256 * 1024;
constexpr size_t WS_WT = 8 * MiB;
constexpr size_t WT_FFN_IN0 = 0, WT_FFN_OUT0 = 11 * MiB, WT_WIN = 16 * MiB + 512 * 1024, WT_PQ = 22 * MiB, WT_ABR = 24 * MiB,
                 WT_FBR = 25 * MiB, WT_WOUT = 26 * MiB, WT_FFN_IN1 = 28 * MiB, WT_FFN_OUT1 = 39 * MiB;
constexpr size_t WS_XB = 56 * MiB;
constexpr size_t WS_R = 184 * MiB;
constexpr size_t R_H = 0, R_QKV = 0, R_GA = 48 * MiB, R_GF = 112 * MiB, R_D0 = 176 * MiB, R_T1 = 240 * MiB, R_AO = 304 * MiB;
constexpr size_t WS_END = WS_R + 368 * MiB;

constexpr int LDS_BYTES = 155648;
constexpr int LDS_RS = 131072 + 4096;
constexpr int LDS_MISC = 131072 + 2048;
constexpr size_t WS_CTL = 0, CTL_BYTES = 16384;
constexpr int LDS_TAB = 131072;

__device__ __forceinline__ unsigned cvt_pk_bf16(float lo, float hi) { unsigned r; asm volatile("v_cvt_pk_bf16_f32 %0, %1, %2" : "=v"(r) : "v"(lo), "v"(hi)); return r; }
__device__ __forceinline__ u32x4 pack8(f32x4 a, f32x4 b) { u32x4 w; w.x = cvt_pk_bf16(a[0], a[1]); w.y = cvt_pk_bf16(a[2], a[3]); w.z = cvt_pk_bf16(b[0], b[1]); w.w = cvt_pk_bf16(b[2], b[3]); return w; }
__device__ __forceinline__ void unpack8(u32x4 w, f32x4& a, f32x4& b) {
    a[0] = __uint_as_float(w.x << 16); a[1] = __uint_as_float(w.x & 0xffff0000u); a[2] = __uint_as_float(w.y << 16); a[3] = __uint_as_float(w.y & 0xffff0000u);
    b[0] = __uint_as_float(w.z << 16); b[1] = __uint_as_float(w.z & 0xffff0000u); b[2] = __uint_as_float(w.w << 16); b[3] = __uint_as_float(w.w & 0xffff0000u);
}
__device__ __forceinline__ unsigned f2bf(float f) { unsigned u = __float_as_uint(f); return (u + 0x7fffu + ((u >> 16) & 1u)) >> 16; }
__device__ __forceinline__ float cos_rev(float x) { return __builtin_amdgcn_cosf(x); }
__device__ __forceinline__ float sin_rev(float x) { return __builtin_amdgcn_sinf(x); }
__device__ __forceinline__ float sigmoidf_(float x) { return __builtin_amdgcn_rcpf(1.0f + __expf(-x)); }
__device__ __forceinline__ float row_rs(const float* ssq, size_t row) {
    const f32x4* p = (const f32x4*)(ssq + row * 16);
    const f32x4 a = p[0], b = p[1], c = p[2], d = p[3];
    const float s = ((a[0] + a[1]) + (a[2] + a[3])) + ((b[0] + b[1]) + (b[2] + b[3])) + ((c[0] + c[1]) + (c[2] + c[3])) + ((d[0] + d[1]) + (d[2] + d[3]));
    return rsqrtf(s * (1.0f / 1024.0f) + EPS);
}

__device__ __forceinline__ void rows_rs8(const float* ssq, int row0, int fq, float (&rs)[2][4]) {
    f32x4 p[2][4];
#pragma unroll
    for (int ai = 0; ai < 2; ++ai)
#pragma unroll
        for (int m = 0; m < 4; ++m) p[ai][m] = *(const f32x4*)(ssq + (size_t)(row0 + ai * 128 + m * 16) * 16 + fq * 4);
#pragma unroll
    for (int ai = 0; ai < 2; ++ai)
#pragma unroll
        for (int m = 0; m < 4; ++m) { float s = (p[ai][m][0] + p[ai][m][1]) + (p[ai][m][2] + p[ai][m][3]); s += __shfl_xor(s, 16); s += __shfl_xor(s, 32); rs[ai][m] = rsqrtf(s * (1.0f / 1024.0f) + EPS); }
    asm volatile("" ::: "memory");
}
__device__ __forceinline__ void rows_rs8_lds(const LAS unsigned char* lds, int rt0, int fq, float (&rs)[2][4]) {
    const LAS f32x4* rp = (const LAS f32x4*)(lds + LDS_RS);
#pragma unroll
    for (int ai = 0; ai < 2; ++ai)
#pragma unroll
        for (int m = 0; m < 4; ++m) { const f32x4 p = rp[(rt0 + ai * 128 + m * 16) * 4 + fq]; float s = (p[0] + p[1]) + (p[2] + p[3]); s += __shfl_xor(s, 16); s += __shfl_xor(s, 32); rs[ai][m] = rsqrtf(s * (1.0f / 1024.0f) + EPS); }
}
__device__ __forceinline__ float wave_sum(float v) {
#pragma unroll
    for (int o = 1; o < 64; o <<= 1) v += __shfl_xor(v, o);
    return v;
}

namespace pg8 {
constexpr int BM = 256, BK = 64, HALF = 128, HTB = HALF * BK * 2, STAGE_BYTES = 8 * HTB, NXCD = 8, WGM = 8;
__host__ __device__ __forceinline__ int lds_byte(int r, int c) { const int st = (r >> 4) * 2 + (c >> 5), rr = r & 15, cc = c & 31, ob = rr * 64 + cc * 2; return st * 1024 + (ob ^ (((ob >> 9) & 1) << 5)); }
__host__ __device__ __forceinline__ void stage_rc(int b, int& R, int& C) { const int st = b / 1024, sb = b % 1024, swz = sb ^ (((sb >> 9) & 1) << 5); R = (st >> 1) * 16 + swz / 64; C = (st & 1) * 32 + (swz % 64) / 2; }
__host__ __device__ __forceinline__ int perm32(int rho) { const int n = rho >> 4, i = rho & 15; return 8 * (i >> 2) + 4 * n + (i & 3); }

struct Unit { int pm, pn; size_t offA, offB; };
struct Gemm { const bf16_t* A; const bf16_t* Bt; int lda, ldb; size_t hstepA, hstepB; int K; };

struct StdOrder {
    int nM, nN, nwg, G, c; size_t tA, tB;
    __device__ void init(int M, int N, int G_, int c_, int lda, int ldb) { nM = M / BM; nN = N / BM; nwg = nM * nN; G = G_; c = c_; tA = (size_t)BM * lda * 2; tB = (size_t)BM * ldb * 2; }
    __device__ bool next(int i, Unit& u) const {
        const long L = (long)i * G + c; if (L >= nwg) return false;
        int wgid = (int)L; { const int q = nwg / NXCD, r = nwg % NXCD, xcd = wgid % NXCD, off = wgid / NXCD; wgid = (xcd < r ? xcd * (q + 1) : r * (q + 1) + (xcd - r) * q) + off; }
        const int nig = WGM * nN, gid = wgid / nig, fm = gid * WGM, gsz = (nM - fm) < WGM ? (nM - fm) : WGM;
        u.pm = fm + ((wgid % nig) % gsz); u.pn = (wgid % nig) / gsz; u.offA = (size_t)u.pm * tA; u.offB = (size_t)u.pn * tB; return true;
    }
};

template <class Epi, class Sched>
__device__ __forceinline__ void gemm_phase(LAS unsigned char* lds, const Gemm g, const Sched& S, const Epi& E) {
    int tid_ = threadIdx.x; asm volatile("" : "+v"(tid_));
    const int tid = tid_, wid = __builtin_amdgcn_readfirstlane(tid >> 6), lane = tid & 63, wr = wid >> 2, wc = wid & 3, fr = lane & 15, fq = lane >> 4;
    int K_ = g.K; asm volatile("" : "+s"(K_));
    const int K = K_, nt = K / BK;
    unsigned voffA[2], voffB[2];
#pragma unroll
    for (int i = 0; i < 2; ++i) { int R, C; stage_rc(tid * 16 + i * 8192, R, C); const int Rb = Epi::PERM ? ((R & ~31) + perm32(R & 31)) : R;
        voffA[i] = (unsigned)(R * g.lda + C) * 2u; voffB[i] = (unsigned)(Rb * g.ldb + C) * 2u; }
    const size_t kstep = (size_t)(BK * 2);
    const size_t hsA = g.hstepA, hsB = g.hstepB;
    const unsigned ldsw = (unsigned)wid * 1024u;
    const int aoff = lds_byte(wr * 64 + fr, fq * 8), boff = lds_byte(wc * 32 + fr, fq * 8);
#define PG8_SA(b, h) (((b) * 2 + (h)) * HTB)
#define PG8_SB(b, h) ((4 + (b) * 2 + (h)) * HTB)
#define PG8_STAGE(bufoff, gbase, voff) do { _Pragma("unroll") for (int _i = 0; _i < 2; ++_i) \
        __builtin_amdgcn_global_load_lds((const unsigned*)((const char*)(gbase) + (voff)[_i]), (LAS unsigned*)(lds + (bufoff) + ldsw + _i * 8192), 16, 0, 0); } while (0)
#define PG8_LDA(dst, b, h) do { _Pragma("unroll") for (int m = 0; m < 4; ++m) _Pragma("unroll") for (int k = 0; k < 2; ++k) dst[m][k] = *(const LAS bf16x8*)(lds + PG8_SA(b, h) + aoff + m * 2048 + k * 1024); } while (0)
#define PG8_LDB(dst, b, h) do { _Pragma("unroll") for (int n = 0; n < 2; ++n) _Pragma("unroll") for (int k = 0; k < 2; ++k) dst[n][k] = *(const LAS bf16x8*)(lds + PG8_SB(b, h) + boff + n * 2048 + k * 1024); } while (0)
#define PG8_MMA(ai, bj, At, Bt) do { __builtin_amdgcn_s_setprio(1); _Pragma("unroll") for (int m = 0; m < 4; ++m) _Pragma("unroll") for (int n = 0; n < 2; ++n) _Pragma("unroll") for (int k = 0; k < 2; ++k) \
        acc[ai][bj][m][n] = __builtin_amdgcn_mfma_f32_16x16x32_bf16(Bt[n][k], At[m][k], acc[ai][bj][m][n], 0, 0, 0); __builtin_amdgcn_s_setprio(0); } while (0)
#define PG8_WAIT_V(n) asm volatile("s_waitcnt vmcnt(" #n ")" ::: "memory")
#define PG8_WAIT_L(n) asm volatile("s_waitcnt lgkmcnt(" #n ")" ::: "memory")
#define PG8_BAR __builtin_amdgcn_s_barrier()
#define PG8_SCHED __builtin_amdgcn_sched_barrier(0)
#define PG8_RSPF(un) do { const char* _s = (const char*)E.ssq + (size_t)(un).pm * (256 * 64) + (size_t)tid * 16; \
        __builtin_amdgcn_global_load_lds((const unsigned*)_s, (LAS unsigned*)(lds + LDS_RS + ldsw), 16, 0, 0); \
        __builtin_amdgcn_global_load_lds((const unsigned*)(_s + 8192), (LAS unsigned*)(lds + LDS_RS + 8192 + ldsw), 16, 0, 0); } while (0)
    Unit cur, nxt; int ui = 0;
    if (!S.next(0, cur)) return;
    if constexpr (Epi::RSPF) PG8_RSPF(cur);
    f32x4 acc[2][2][4][2];
#pragma unroll
    for (int a = 0; a < 2; ++a)
#pragma unroll
        for (int b = 0; b < 2; ++b)
#pragma unroll
            for (int m = 0; m < 4; ++m)
#pragma unroll
                for (int n = 0; n < 2; ++n) acc[a][b][m][n] = (f32x4){0.f, 0.f, 0.f, 0.f};
    bf16x8 At[4][2], B0[2][2], B1[2][2];
    const char* cA = (const char*)g.A + cur.offA; const char* cB = (const char*)g.Bt + cur.offB;
    PG8_STAGE(PG8_SB(0, 0), cB, voffB); PG8_STAGE(PG8_SB(0, 1), cB + hsB, voffB); PG8_STAGE(PG8_SA(0, 0), cA, voffA); PG8_STAGE(PG8_SA(0, 1), cA + hsA, voffA);
    if (wr == 1) PG8_BAR;
    PG8_WAIT_V(2); PG8_BAR;
    PG8_STAGE(PG8_SB(1, 0), cB + kstep, voffB); PG8_STAGE(PG8_SA(1, 0), cA + kstep, voffA); PG8_STAGE(PG8_SB(1, 1), cB + hsB + kstep, voffB);
    PG8_WAIT_V(6); PG8_BAR;
    for (;;) {
        const bool has_next = S.next(ui + 1, nxt);
        const char* nA = has_next ? (const char*)g.A + nxt.offA : cA; const char* nB = has_next ? (const char*)g.Bt + nxt.offB : cB;
        for (int t = 0; t < nt; t += 2) {
            const bool last = (t == nt - 2);
            const char* a1 = cA + (size_t)(t + 1) * kstep;
            const char* a2 = last ? nA : cA + (size_t)(t + 2) * kstep; const char* b2 = last ? nB : cB + (size_t)(t + 2) * kstep;
            const char* a3 = a2 + kstep; const char* b3 = b2 + kstep;
            if constexpr (Epi::MIDK) { if (t == (nt >> 1)) { int fr_ = fr, fq_ = fq; asm volatile("" : "+v"(fr_), "+v"(fq_)); E.mid(acc, cur, wr, wc, fr_, fq_); } }
            PG8_LDB(B0, 0, 0); PG8_LDB(B1, 0, 1); PG8_SCHED; PG8_LDA(At, 0, 0); PG8_STAGE(PG8_SA(1, 1), a1 + hsA, voffA);
            PG8_WAIT_V(8); PG8_WAIT_L(0); PG8_BAR; PG8_MMA(0, 0, At, B0); PG8_MMA(0, 1, At, B1); PG8_BAR; PG8_SCHED;
            PG8_LDA(At, 0, 1); PG8_STAGE(PG8_SB(0, 0), b2, voffB); PG8_STAGE(PG8_SB(0, 1), b2 + hsB, voffB); PG8_STAGE(PG8_SA(0, 0), a2, voffA);
            PG8_WAIT_V(8); PG8_WAIT_L(0); PG8_BAR; PG8_MMA(1, 0, At, B0); PG8_MMA(1, 1, At, B1); PG8_BAR; PG8_SCHED;
            PG8_LDB(B0, 1, 0); PG8_LDB(B1, 1, 1); PG8_SCHED; PG8_LDA(At, 1, 0); PG8_STAGE(PG8_SA(0, 1), a2 + hsA, voffA);
            PG8_WAIT_V(8); PG8_WAIT_L(0); PG8_BAR; PG8_MMA(0, 0, At, B0); PG8_MMA(0, 1, At, B1); PG8_BAR; PG8_SCHED;
            PG8_LDA(At, 1, 1); PG8_STAGE(PG8_SB(1, 0), b3, voffB); PG8_STAGE(PG8_SB(1, 1), b3 + hsB, voffB); PG8_STAGE(PG8_SA(1, 0), a3, voffA);
            PG8_WAIT_V(8); PG8_WAIT_L(0); PG8_BAR; PG8_MMA(1, 0, At, B0); PG8_MMA(1, 1, At, B1); PG8_BAR; PG8_SCHED;
        }
        if (wr == 0) PG8_BAR;
        { int fr_ = fr, fq_ = fq; asm volatile("" : "+v"(fr_), "+v"(fq_));
          if constexpr (Epi::RSPF) {
              float rsv[2][4]; rows_rs8_lds(lds, wr * 64 + fr_, fq_, rsv);
              PG8_WAIT_L(0); PG8_BAR;
              if (has_next) PG8_RSPF(nxt);
              E(acc, cur, wr, wc, fr_, fq_, rsv);
          } else E(acc, cur, wr, wc, fr_, fq_); }
        if (!has_next) break;
#pragma unroll
        for (int a = 0; a < 2; ++a)
#pragma unroll
            for (int b = 0; b < 2; ++b)
#pragma unroll
                for (int m = 0; m < 4; ++m)
#pragma unroll
                    for (int n = 0; n < 2; ++n) acc[a][b][m][n] = (f32x4){0.f, 0.f, 0.f, 0.f};
        cur = nxt; cA = nA; cB = nB; ++ui;
        if (wr == 1) PG8_BAR;
    }
    PG8_WAIT_V(0);
    PG8_BAR;
#undef PG8_RSPF
#undef PG8_SA
#undef PG8_SB
#undef PG8_STAGE
#undef PG8_LDA
#undef PG8_LDB
#undef PG8_MMA
#undef PG8_WAIT_V
#undef PG8_WAIT_L
#undef PG8_BAR
#undef PG8_SCHED
}
}
using pg8::Unit;
typedef f32x4 Acc[2][2][4][2];

struct EpiSwiGLU { static constexpr bool MIDK = false; static constexpr bool RSPF = true; static constexpr bool PERM = true; bf16_t* H; const float* ssq; const LAS unsigned char* lds;
    __device__ __forceinline__ void operator()(const Acc& acc, const Unit& u, int wr, int wc, int fr, int fq, const float (&rsv)[2][4]) const {
        const int row0 = u.pm * 256 + wr * 64 + fr; const int hc = u.pn * 128 + wc * 32 + 8 * fq;
#pragma unroll
        for (int ai = 0; ai < 2; ++ai)
#pragma unroll
            for (int m = 0; m < 4; ++m) { const size_t row = (size_t)(row0 + ai * 128 + m * 16); const float rs = rsv[ai][m];
                const float c1 = rs * -1.4426950408889634f, c2 = rs * rs;
                f32x4 h[2];
#pragma unroll
                for (int n = 0; n < 2; ++n)
#pragma unroll
                    for (int p = 0; p < 2; ++p) { const f32x2v g = (f32x2v){acc[ai][0][m][n][2 * p], acc[ai][0][m][n][2 * p + 1]}, uu = (f32x2v){acc[ai][1][m][n][2 * p], acc[ai][1][m][n][2 * p + 1]};
                        const f32x2v a = g * c1; f32x2v d = (f32x2v){__builtin_amdgcn_exp2f(a.x), __builtin_amdgcn_exp2f(a.y)}; d = d + 1.0f;
                        const f32x2v t = (f32x2v){__builtin_amdgcn_rcpf(d.x), __builtin_amdgcn_rcpf(d.y)}; const f32x2v hv = ((g * uu) * c2) * t;
                        h[n][2 * p] = hv.x; h[n][2 * p + 1] = hv.y; }
                *(u32x4*)(H + row * DFF + hc) = pack8(h[0], h[1]); }
    }
};
struct EpiResid { static constexpr bool MIDK = false; static constexpr bool RSPF = false; static constexpr bool PERM = true; bf16_t* xb; float* ssq; float* outf; float scale;
    __device__ __forceinline__ void operator()(const Acc& acc, const Unit& u, int wr, int wc, int fr, int fq) const {
        const int row0 = u.pm * 256 + wr * 64 + fr; const int c8 = u.pn * 256 + wc * 32 + 8 * fq;
#pragma unroll
        for (int ai = 0; ai < 2; ++ai) { u32x4 bv[4][2];
#pragma unroll
            for (int m = 0; m < 4; ++m)
#pragma unroll
                for (int bj = 0; bj < 2; ++bj) bv[m][bj] = *(const u32x4*)(xb + (size_t)(row0 + ai * 128 + m * 16) * DM + c8 + bj * 128);
#pragma unroll
            for (int m = 0; m < 4; ++m) { const size_t row = (size_t)(row0 + ai * 128 + m * 16); float s = 0.f;
#pragma unroll
                for (int bj = 0; bj < 2; ++bj) { const size_t off = row * DM + c8 + bj * 128; f32x4 b0, b1; unpack8(bv[m][bj], b0, b1);
                    const f32x4 o0 = b0 + acc[ai][bj][m][0] * scale, o1 = b1 + acc[ai][bj][m][1] * scale;
                    if (outf) { *(f32x4*)(outf + off) = o0; *(f32x4*)(outf + off + 4) = o1; }
                    if (!outf) *(u32x4*)(xb + off) = pack8(o0, o1);
                    s += ((o0[0] * o0[0] + o0[1] * o0[1]) + (o0[2] * o0[2] + o0[3] * o0[3])) + ((o1[0] * o1[0] + o1[1] * o1[1]) + (o1[2] * o1[2] + o1[3] * o1[3])); }
                s += __shfl_xor(s, 16); s += __shfl_xor(s, 32);
                if (fq == 0 && !outf) ssq[row * 16 + u.pn * 4 + wc] = s; }
            asm volatile("" ::: "memory"); }
    }
};
struct EpiWin { static constexpr bool MIDK = false; static constexpr bool RSPF = true; static constexpr bool PERM = true; bf16_t* qkv; bf16_t* gr; bf16_t* gf; const float* ssq; const LAS unsigned char* lds;
    __device__ __forceinline__ void operator()(const Acc& acc, const Unit& u, int wr, int wc, int fr, int fq, const float (&rsv)[2][4]) const {
        const int row0 = u.pm * 256 + wr * 64 + fr; const int c8 = wc * 32 + 8 * fq;
        const bool gate = u.pn >= 3;
#pragma unroll
        for (int ai = 0; ai < 2; ++ai)
#pragma unroll
            for (int m = 0; m < 4; ++m) { const size_t row = (size_t)(row0 + ai * 128 + m * 16); const float rs = rsv[ai][m];
                if (!gate) {
#pragma unroll
                    for (int bj = 0; bj < 2; ++bj) *(u32x4*)(qkv + row * 768 + u.pn * 256 + bj * 128 + c8) = pack8(acc[ai][bj][m][0] * rs, acc[ai][bj][m][1] * rs);
                } else { const float c1 = rs * -1.4426950408889634f; f32x4 r0, r1, g0, g1;
#pragma unroll
                    for (int n = 0; n < 2; ++n)
#pragma unroll
                        for (int p = 0; p < 2; ++p) { const f32x2v xa = (f32x2v){acc[ai][0][m][n][2 * p], acc[ai][0][m][n][2 * p + 1]} * c1, xf = (f32x2v){acc[ai][1][m][n][2 * p], acc[ai][1][m][n][2 * p + 1]} * c1;
                            const f32x2v da = (f32x2v){__builtin_amdgcn_exp2f(xa.x), __builtin_amdgcn_exp2f(xa.y)} + 1.0f;
                            const f32x2v df = (f32x2v){fminf(__builtin_amdgcn_exp2f(xf.x), 1e30f), fminf(__builtin_amdgcn_exp2f(xf.y), 1e30f)} + 1.0f;
                            const f32x2v sa = (f32x2v){__builtin_amdgcn_rcpf(da.x), __builtin_amdgcn_rcpf(da.y)}, sf = (f32x2v){__builtin_amdgcn_rcpf(df.x), __builtin_amdgcn_rcpf(df.y)};
                            const f32x2v rr = df * sa;
                            if (n == 0) { r0[2 * p] = rr.x; r0[2 * p + 1] = rr.y; g0[2 * p] = sf.x; g0[2 * p + 1] = sf.y; } else { r1[2 * p] = rr.x; r1[2 * p + 1] = rr.y; g1[2 * p] = sf.x; g1[2 * p + 1] = sf.y; } }
                    const size_t off = row * DM + (u.pn - 3) * 128 + c8;
                    *(u32x4*)(gr + off) = pack8(r0, r1); *(u32x4*)(gf + off) = pack8(g0, g1); } }
    }
};
struct EpiPQ { static constexpr bool MIDK = false; static constexpr bool RSPF = false; static constexpr bool PERM = true; bf16_t* d0; const float* ssq; int N1, S;
    __device__ __forceinline__ void operator()(const Acc& acc, const Unit& u, int wr, int wc, int fr, int fq) const {
        const int hp = N1 >> 1; const int b = u.pn / hp, sp = u.pn % hp; const int s2b = wc * 32 + 8 * fq;
        const float myrs = row_rs(ssq, (size_t)(b * S + 2 * sp + (fr >> 3) + N1 * (s2b + (fr & 7))));
        float rsv[2][8];
#pragma unroll
        for (int bj = 0; bj < 2; ++bj)
#pragma unroll
            for (int e = 0; e < 8; ++e) rsv[bj][e] = __shfl(myrs, (fq << 4) | (bj * 8 + e));
        asm volatile("" ::: "memory");
#pragma unroll
        for (int ai = 0; ai < 2; ++ai)
#pragma unroll
            for (int m = 0; m < 4; ++m) { const int chn = u.pm * 256 + ai * 128 + wr * 64 + m * 16 + fr; const int part = chn >> 9, c = chn & 511;
#pragma unroll
                for (int bj = 0; bj < 2; ++bj) { f32x4 v0 = acc[ai][bj][m][0], v1 = acc[ai][bj][m][1];
#pragma unroll
                    for (int i = 0; i < 4; ++i) { v0[i] *= rsv[bj][i]; v1[i] *= rsv[bj][4 + i]; }
                    const size_t idx = ((size_t)(b * 512 + c) * N1 + (2 * sp + bj)) * 256 + part * 128 + s2b;
                    *(u32x4*)(d0 + idx) = pack8(v0, v1); } asm volatile("" ::: "memory"); }
    }
};
struct EpiDft1 { static constexpr bool MIDK = false; static constexpr bool RSPF = false; static constexpr bool PERM = true; bf16_t* t1p; int N1, lgN1, S; float invS;
    __device__ __forceinline__ void operator()(const Acc& acc, const Unit& u, int wr, int wc, int fr, int fq) const {
#pragma unroll
        for (int m = 0; m < 4; ++m) { const int k2 = wr * 64 + m * 16 + fr; const float dl = (float)k2 * invS;
#pragma unroll
            for (int bj = 0; bj < 2; ++bj) { const int j0 = u.pn * 256 + bj * 128 + wc * 32 + 8 * fq; const int s10 = j0 & (N1 - 1); const int bc = j0 >> lgN1;
                const float ph0 = (float)((s10 * k2) & (S - 1)) * invS;
                const size_t idx = (((size_t)bc * 128 + k2) * 2) * N1 + s10;
                u32x4 wu, wv;
#pragma unroll
                for (int n = 0; n < 2; ++n) { float uo[4], vo[4];
#pragma unroll
                    for (int i = 0; i < 4; ++i) { const float ph = ph0 + (float)(4 * n + i) * dl;
                        const float cs = cos_rev(ph), sn = sin_rev(ph); const float U = acc[0][bj][m][n][i], V = acc[1][bj][m][n][i];
                        uo[i] = cs * U - sn * V; vo[i] = sn * U + cs * V; }
                    const unsigned u0 = cvt_pk_bf16(uo[0], uo[1]), u1 = cvt_pk_bf16(uo[2], uo[3]), v0 = cvt_pk_bf16(vo[0], vo[1]), v1 = cvt_pk_bf16(vo[2], vo[3]);
                    if (n == 0) { wu.x = u0; wu.y = u1; wv.x = v0; wv.y = v1; } else { wu.z = u0; wu.w = u1; wv.z = v0; wv.w = v1; } }
                *(u32x4*)(t1p + idx) = wu; *(u32x4*)(t1p + idx + N1) = wv; asm volatile("" ::: "memory"); } }
    }
};
struct EpiDft2 { static constexpr bool MIDK = false; static constexpr bool RSPF = false; static constexpr bool PERM = true; bf16_t* fo; int N1, lgN1, S;
    __device__ __forceinline__ void operator()(const Acc& acc, const Unit& u, int wr, int wc, int fr, int fq) const {
        const int ng = N1 >> 1; const int chalf = u.pn & 1, k2g = (u.pn >> 1) % ng, b = (u.pn >> 1) / ng; const int kper = 256 >> lgN1;
#pragma unroll
        for (int ai = 0; ai < 2; ++ai)
#pragma unroll
            for (int m = 0; m < 4; ++m) { const int r = ai * 128 + wr * 64 + m * 16 + fr; const int k2s = r >> lgN1, k1 = r & (N1 - 1);
                const size_t tok = (size_t)b * S + 128 * k1 + k2g * kper + k2s;
#pragma unroll
                for (int bj = 0; bj < 2; ++bj) *(u32x4*)(fo + tok * 1024 + 512 + chalf * 256 + bj * 128 + wc * 32 + 8 * fq) = pack8(acc[ai][bj][m][0], acc[ai][bj][m][1]); }
    }
};
struct EpiBr { static constexpr bool MIDK = true; static constexpr bool RSPF = false; static constexpr bool PERM = true; const bf16_t* gr; const bf16_t* gf; bf16_t* gated;
    __device__ __forceinline__ void mid(Acc& acc, const Unit& u, int wr, int wc, int fr, int fq) const {
        const int row0 = u.pm * 256 + wr * 64 + fr; const int c8 = u.pn * 256 + wc * 32 + 8 * fq;
        u32x4 rv[2][4][2];
#pragma unroll
        for (int ai = 0; ai < 2; ++ai)
#pragma unroll
            for (int m = 0; m < 4; ++m)
#pragma unroll
                for (int bj = 0; bj < 2; ++bj) rv[ai][m][bj] = *(const u32x4*)(gr + (size_t)(row0 + ai * 128 + m * 16) * DM + c8 + bj * 128);
#pragma unroll
        for (int ai = 0; ai < 2; ++ai)
#pragma unroll
            for (int m = 0; m < 4; ++m)
#pragma unroll
                for (int bj = 0; bj < 2; ++bj) { f32x4 a0, a1; unpack8(rv[ai][m][bj], a0, a1); acc[ai][bj][m][0] *= a0; acc[ai][bj][m][1] *= a1; }
    }
    __device__ __forceinline__ void operator()(const Acc& acc, const Unit& u, int wr, int wc, int fr, int fq) const {
        const int row0 = u.pm * 256 + wr * 64 + fr; const int c8 = u.pn * 256 + wc * 32 + 8 * fq;
        u32x4 fv[2][4][2];
#pragma unroll
        for (int ai = 0; ai < 2; ++ai)
#pragma unroll
            for (int m = 0; m < 4; ++m)
#pragma unroll
                for (int bj = 0; bj < 2; ++bj) fv[ai][m][bj] = *(const u32x4*)(gf + (size_t)(row0 + ai * 128 + m * 16) * DM + c8 + bj * 128);
#pragma unroll
        for (int ai = 0; ai < 2; ++ai)
#pragma unroll
            for (int m = 0; m < 4; ++m)
#pragma unroll
                for (int bj = 0; bj < 2; ++bj) { const size_t off = (size_t)(row0 + ai * 128 + m * 16) * DM + c8 + bj * 128; f32x4 g0, g1; unpack8(fv[ai][m][bj], g0, g1);
                    *(u32x4*)(gated + off) = pack8(g0 * acc[ai][bj][m][0], g1 * acc[ai][bj][m][1]); }
    }
};

struct OrderPQ {
    int G, c, N1, S;
    __device__ bool next(int i, Unit& u) const { const int L = i * G + c; if (L >= 4 * 128) return false; u.pm = L & 3; u.pn = L >> 2;
        const int hp = N1 >> 1; const int b = u.pn / hp, sp = u.pn % hp; u.offA = (size_t)u.pm * 256 * 1024 * 2; u.offB = ((size_t)b * S + 2 * sp) * 1024 * 2; return true; }
};
struct OrderWin {
    int G, vcu, lo, hi;
    __device__ bool next(int i, Unit& u) const { const int v = lo + vcu + G * i; if (v >= hi) return false;
        if (v < 384) { u.pm = (v * 21846) >> 16; u.pn = v - 3 * u.pm; } else { const int w = v - 384; u.pm = w >> 3; u.pn = 3 + (w & 7); }
        u.offA = (size_t)u.pm * 256 * 1024 * 2; u.offB = (size_t)u.pn * 256 * 1024 * 2; return true; }
};
struct OrderD1b {
    int G, c, vcu;
    __device__ bool next(int i, Unit& u) const { int L;
        if (G == 256) { if (vcu < 128) { if (i >= 1) return false; L = vcu; } else { if (i >= 3) return false; L = 128 + (vcu - 128) * 3 + i; } }
        else { L = i * G + c; if (L >= 512) return false; }
        u.pm = 0; u.pn = L; u.offA = 0; u.offB = (size_t)L * 256 * 256 * 2; return true; }
};
struct OrderD1 {
    int G, c;
    __device__ bool next(int i, Unit& u) const { const int L = i * G + c; if (L >= 512) return false; u.pm = 0; u.pn = L; u.offA = 0; u.offB = (size_t)L * 256 * 256 * 2; return true; }
};
struct OrderD2 {
    int G, c, N1;
    __device__ bool next(int i, Unit& u) const { const int L = i * G + c; if (L >= 256) return false; u.pm = 0; u.pn = L; const int ng = N1 >> 1;
        const int chalf = L & 1, k2g = (L >> 1) % ng, b = (L >> 1) / ng; u.offA = 0; u.offB = (((size_t)b * 512 + chalf * 256) * (256 * (size_t)N1) + (size_t)k2g * 512) * 2; return true; }
};

constexpr int KP = 72, VP = 408;
__device__ __forceinline__ void attn_unit(LAS unsigned char* lds, const bf16_t* qkv, bf16_t* ao, const float* qg, const float* kg, const float* sink, int b, int nb, int kvh, int S) {
    int tid_ = threadIdx.x; asm volatile("" : "+v"(tid_));
    const int tid = tid_, lane = tid & 63, wid = __builtin_amdgcn_readfirstlane(tid >> 6), fr = lane & 15, fq = lane >> 4;
    LAS bf16_t* Ks = (LAS bf16_t*)lds;
    LAS bf16_t* Vt = (LAS bf16_t*)(lds + 384 * KP * 2);
    for (int i = tid; i < 64 * 24; i += 512) { const int d = i / 24, cc = 384 + i % 24; Vt[d * VP + cc] = 0; }
#pragma unroll 1
    for (int it = 0; it < 6; ++it) { const int i = tid + 512 * it; const int key = i >> 3, ch = i & 7; const int s = nb * 128 - 128 + key; const bool ok = (s >= 0 && s < S);
        u32x4 kw = (u32x4){0u, 0u, 0u, 0u}, vw = (u32x4){0u, 0u, 0u, 0u};
        if (ok) { const bf16_t* p = qkv + ((size_t)b * S + s) * 768 + 512 + kvh * 64 + ch * 8; kw = *(const u32x4*)p; vw = *(const u32x4*)(p + 128); }
        f32x4 k0, k1; unpack8(kw, k0, k1);
        float ss = (k0[0] * k0[0] + k0[1] * k0[1]) + (k0[2] * k0[2] + k0[3] * k0[3]) + (k1[0] * k1[0] + k1[1] * k1[1]) + (k1[2] * k1[2] + k1[3] * k1[3]);
        ss += __shfl_xor(ss, 1); ss += __shfl_xor(ss, 2); ss += __shfl_xor(ss, 4);
        const float rk = rsqrtf(ss * (1.0f / 64.0f) + EPS);
        const f32x4 g0 = *(const f32x4*)(kg + ch * 8), g1 = *(const f32x4*)(kg + ch * 8 + 4);
        *(LAS u32x4*)(Ks + key * KP + ch * 8) = pack8(k0 * g0 * rk, k1 * g1 * rk);
        const unsigned vv[4] = {vw.x, vw.y, vw.z, vw.w};
#pragma unroll
        for (int e = 0; e < 4; ++e) { Vt[(ch * 8 + 2 * e) * VP + key] = (bf16_t)(vv[e] & 0xffffu); Vt[(ch * 8 + 2 * e + 1) * VP + key] = (bf16_t)(vv[e] >> 16); }
    }
    __syncthreads();
    const int g = wid >> 1, qh = wid & 1, h = kvh * 4 + g;
    constexpr float LOG2E = 1.4426950408889634f; const int nblk = S >> 7;
    const float sl = exp2f(-(float)(h + 1)) * LOG2E; const float snk2 = sink[h] * LOG2E;
    const f32x4 qg0 = *(const f32x4*)(qg + fq * 8), qg1 = *(const f32x4*)(qg + fq * 8 + 4), qg2 = *(const f32x4*)(qg + 32 + fq * 8), qg3 = *(const f32x4*)(qg + 32 + fq * 8 + 4);
#pragma unroll 1
    for (int i4 = 0; i4 < 4; ++i4) { const int qt = qh * 4 + i4; const int q0 = qt * 16;
        const size_t tok = (size_t)b * S + nb * 128 + q0 + fr;
        const bf16_t* qp = qkv + tok * 768 + h * 64 + fq * 8;
        f32x4 a0, a1, a2, a3; unpack8(*(const u32x4*)qp, a0, a1); unpack8(*(const u32x4*)(qp + 32), a2, a3);
        float ss = 0.f;
#pragma unroll
        for (int i = 0; i < 4; ++i) ss += a0[i] * a0[i] + a1[i] * a1[i] + a2[i] * a2[i] + a3[i] * a3[i];
        ss += __shfl_xor(ss, 16); ss += __shfl_xor(ss, 32);
        const float rq = rsqrtf(ss * (1.0f / 64.0f) + EPS) * 0.125f;
        const bf16x8 qa0 = __builtin_bit_cast(bf16x8, pack8(a0 * qg0 * rq, a1 * qg1 * rq)), qa1 = __builtin_bit_cast(bf16x8, pack8(a2 * qg2 * rq, a3 * qg3 * rq));
        f32x4 st[17];
#pragma unroll
        for (int t = 0; t < 17; ++t) { const LAS bf16_t* kp = Ks + (16 * (qt + t) + fr) * KP + fq * 8;
            const bf16x8 kf0 = *(const LAS bf16x8*)kp, kf1 = *(const LAS bf16x8*)(kp + 32);
            f32x4 z = (f32x4){0.f, 0.f, 0.f, 0.f};
            z = __builtin_amdgcn_mfma_f32_16x16x32_bf16(kf0, qa0, z, 0, 0, 0);
            st[t] = __builtin_amdgcn_mfma_f32_16x16x32_bf16(kf1, qa1, z, 0, 0, 0); }
        const int c = fr - 4 * fq; const float A1 = -sl * (float)c;
        float mx = -1e30f;
#pragma unroll
        for (int t = 0; t < 17; ++t)
#pragma unroll
            for (int jj = 0; jj < 4; ++jj) { float bias;
                if (t < 8) bias = __builtin_fmaf(-sl, (float)(128 - 16 * t - jj), A1);
                else if (t > 8) bias = __builtin_fmaf(-sl, (float)(16 * t + jj - 128), -A1);
                else { const int d = c - jj; bias = -sl * (float)(d < 0 ? -d : d); }
                float v = __builtin_fmaf(st[t][jj], LOG2E, bias);
                if (t == 0) v = (c > jj) ? -1e30f : v;
                if (t == 16) v = (jj > c) ? -1e30f : v;
                st[t][jj] = v; }
        if (nb == 0) { const int e0 = q0 + 4 * fq;
#pragma unroll
            for (int t = 0; t < 8; ++t)
#pragma unroll
                for (int jj = 0; jj < 4; ++jj) st[t][jj] = (e0 + jj < 128 - 16 * t) ? -1e30f : st[t][jj]; }
        if (nb == nblk - 1) { const int e0 = q0 + 4 * fq;
#pragma unroll
            for (int t = 9; t < 17; ++t)
#pragma unroll
                for (int jj = 0; jj < 4; ++jj) st[t][jj] = (e0 + jj >= 256 - 16 * t) ? -1e30f : st[t][jj]; }
#pragma unroll
        for (int t = 0; t < 17; ++t) mx = fmaxf(fmaxf(mx, fmaxf(st[t][0], st[t][1])), fmaxf(st[t][2], st[t][3]));
        mx = fmaxf(mx, __shfl_xor(mx, 16)); mx = fmaxf(mx, __shfl_xor(mx, 32)); mx = fmaxf(mx, snk2);
        float sum = 0.f;
#pragma unroll
        for (int t = 0; t < 17; ++t)
#pragma unroll
            for (int jj = 0; jj < 4; ++jj) { const float p = __builtin_amdgcn_exp2f(st[t][jj] - mx); st[t][jj] = p; sum += p; }
        sum += __shfl_xor(sum, 16); sum += __shfl_xor(sum, 32); sum += __builtin_amdgcn_exp2f(snk2 - mx);
        const float inv = 1.0f / sum;
        f32x4 o[4];
#pragma unroll
        for (int dt = 0; dt < 4; ++dt) o[dt] = (f32x4){0.f, 0.f, 0.f, 0.f};
#pragma unroll
        for (int uu = 0; uu < 9; ++uu) { const f32x4 zero4 = (f32x4){0.f, 0.f, 0.f, 0.f};
            const bf16x8 pb = __builtin_bit_cast(bf16x8, pack8(st[2 * uu], (2 * uu + 1 < 17) ? st[(2 * uu + 1 < 17) ? 2 * uu + 1 : 16] : zero4));
#pragma unroll
            for (int dt = 0; dt < 4; ++dt) { const LAS bf16_t* vp = Vt + (16 * dt + fr) * VP + 16 * (qt + 2 * uu) + 4 * fq;
                const u32x2 lo = *(const LAS u32x2*)vp, hi = *(const LAS u32x2*)(vp + 16);
                const bf16x8 va = __builtin_bit_cast(bf16x8, (u32x4){lo.x, lo.y, hi.x, hi.y});
                o[dt] = __builtin_amdgcn_mfma_f32_16x16x32_bf16(va, pb, o[dt], 0, 0, 0); } }
        bf16_t* op = ao + tok * 1024 + h * 64 + 4 * fq;
#pragma unroll
        for (int dt = 0; dt < 4; ++dt) { u32x2 w; w.x = cvt_pk_bf16(o[dt][0] * inv, o[dt][1] * inv); w.y = cvt_pk_bf16(o[dt][2] * inv, o[dt][3] * inv); *(u32x2*)(op + 16 * dt) = w; }
    }
    __syncthreads();
}

__device__ __forceinline__ void tr_item(const float* W, int ldw, int K, int k0, int src0, int dst0, bf16_t* WT, const float* gain, LAS float* scr, int lane, int kd = 0) {
    { f32x4 v[8]; const int c4 = (lane & 7) * 4;
#pragma unroll
      for (int i = 0; i < 8; ++i) v[i] = *(const f32x4*)(W + (size_t)(k0 + 8 * i + (lane >> 3)) * ldw + src0 + c4);
#pragma unroll
      for (int i = 0; i < 8; ++i) { const int kk = 8 * i + (lane >> 3); const float gk = gain ? gain[k0 + kk] : 1.0f;
#pragma unroll
          for (int j = 0; j < 4; ++j) scr[kk * 33 + c4 + j] = v[i][j] * gk; } }
    asm volatile("s_waitcnt lgkmcnt(0)" ::: "memory");
    const int c = lane & 7;
#pragma unroll
    for (int j = 0; j < 4; ++j) { const int n = (lane >> 3) + 8 * j; const LAS float* s = scr + (8 * c) * 33 + n;
        u32x4 o; o.x = cvt_pk_bf16(s[0 * 33], s[1 * 33]); o.y = cvt_pk_bf16(s[2 * 33], s[3 * 33]); o.z = cvt_pk_bf16(s[4 * 33], s[5 * 33]); o.w = cvt_pk_bf16(s[6 * 33], s[7 * 33]);
        *(u32x4*)(WT + (size_t)(dst0 + n) * K + kd + k0 + 8 * c) = o; }
    asm volatile("s_waitcnt lgkmcnt(0)" ::: "memory");
}

struct Args {
    const float* xin[2]; const float* ln_ffn1; const float* w_ffn1_in; const float* w_ffn1_out; const float* ln_mix; const float* w_in;
    const float* q_gain; const float* k_gain; const float* sink; const float* w_attn_br; const float* w_four_br; const float* w_out;
    const float* ln_ffn2; const float* w_ffn2_in; const float* w_ffn2_out; float* out; unsigned char* ws;
};

__device__ __forceinline__ void convert_layer(const Args& a, int l, LAS unsigned char* lds, int G) {
    int tid_ = threadIdx.x; asm volatile("" : "+v"(tid_));
    const int tid = tid_, lane = tid & 63, wid = __builtin_amdgcn_readfirstlane(tid >> 6);
    LAS float* scr = (LAS float*)(lds + wid * 16384);
    LAS float* tab = (LAS float*)(lds + LDS_TAB);
    if (tid < 128) { tab[tid] = cos_rev((float)tid * (1.0f / 128.0f)); tab[128 + tid] = sin_rev((float)tid * (1.0f / 128.0f)); }
    __syncthreads();
    unsigned char* wt = a.ws + WS_WT;
    const int gw = blockIdx.x * 8 + wid, NGW = G * 8;
    constexpr int I0 = 16 * 176, I1 = 44 * 32, I2 = 16 * 88, I3 = 8 * 32, I4 = 8 * 32, I5 = 16 * 32, I6 = I0, I7 = I1;
    constexpr int NTR = I0 + I1 + I2 + I3 + I4 + I5 + I6 + I7;
    for (int it = gw; it < NTR; it += NGW) {
        int r = it;
        if (r < I0 || (r >= I0 + I1 + I2 + I3 + I4 + I5 && r < NTR - I7)) {
            const bool second = r >= I0; if (second) r -= I0 + I1 + I2 + I3 + I4 + I5;
            const float* W = (second ? a.w_ffn2_in : a.w_ffn1_in) + (size_t)l * DM * 2 * DFF; const float* gn = (second ? a.ln_ffn2 : a.ln_ffn1) + l * DM;
            const int kb = r / 176, nb = r % 176; const int n0 = nb * 32; const int t = n0 >> 8, hh = (n0 >> 7) & 1, i0 = n0 & 127;
            tr_item(W, 2 * DFF, DM, kb * 64, hh * DFF + 128 * t + i0, n0, (bf16_t*)(wt + (second ? WT_FFN_IN1 : WT_FFN_IN0)), gn, scr, lane); continue; }
        r -= I0;
        if (r < I1) { const int kb = r / 32, nb = r % 32; tr_item(a.w_ffn1_out + (size_t)l * DFF * DM, DM, DFF, kb * 64, nb * 32, nb * 32, (bf16_t*)(wt + WT_FFN_OUT0), nullptr, scr, lane); continue; }
        r -= I1;
        if (r < I2) { const int kb = r / 88, nb = r % 88; const int n0 = nb * 32; tr_item(a.w_in + (size_t)l * DM * WIN_COLS, WIN_COLS, DM, kb * 64, n0 < 768 ? n0 : 1280 + (((n0 - 768) >> 7) & 1) * 1024 + ((n0 - 768) >> 8) * 128 + ((n0 - 768) & 127), n0, (bf16_t*)(wt + WT_WIN), a.ln_mix + l * DM, scr, lane); continue; }
        r -= I2;
        if (r < I3) { const int kb = r / 32, nb = r % 32; tr_item(a.w_attn_br + (size_t)l * 512 * DM, DM, 1024, kb * 64, nb * 32, nb * 32, (bf16_t*)(wt + WT_ABR), nullptr, scr, lane, 0); continue; }
        r -= I3;
        if (r < I4) { const int kb = r / 32, nb = r % 32; tr_item(a.w_four_br + (size_t)l * 512 * DM, DM, 1024, kb * 64, nb * 32, nb * 32, (bf16_t*)(wt + WT_ABR), nullptr, scr, lane, 512); continue; }
        r -= I4;
        if (r < I5) { const int kb = r / 32, nb = r % 32; tr_item(a.w_out + (size_t)l * DM * DM, DM, DM, kb * 64, nb * 32, nb * 32, (bf16_t*)(wt + WT_WOUT), nullptr, scr, lane); continue; }
        r -= I5 + I6;
        { const int kb = r / 32, nb = r % 32; tr_item(a.w_ffn2_out + (size_t)l * DFF * DM, DM, DFF, kb * 64, nb * 32, nb * 32, (bf16_t*)(wt + WT_FFN_OUT1), nullptr, scr, lane); }
    }
    bf16_t* pq = (bf16_t*)(wt + WT_PQ); const float* Wl = a.w_in + (size_t)l * DM * WIN_COLS; const float* gm = a.ln_mix + l * DM;
    for (int it = gw; it < DM * 4; it += NGW) { const int k = it >> 2, grp = it & 3;
        const float* wrow = Wl + (size_t)k * WIN_COLS + 768 + grp * 128; const float w0 = wrow[lane], w1 = wrow[64 + lane];
        float pc0 = 0.f, ps0 = 0.f, pc1 = 0.f, ps1 = 0.f;
        for (int c = 0; c < 128; ++c) { const float w = __shfl(c < 64 ? w0 : w1, c & 63); const int j0 = (c * lane) & 127, j1 = (c * (lane + 64)) & 127;
            pc0 += w * tab[j0]; ps0 += w * tab[128 + j0]; pc1 += w * tab[j1]; ps1 += w * tab[128 + j1]; }
        const float gk = gm[k];
        pq[(size_t)(grp * 128 + lane) * DM + k] = (bf16_t)f2bf(pc0 * gk); pq[(size_t)(grp * 128 + 64 + lane) * DM + k] = (bf16_t)f2bf(pc1 * gk);
        pq[(size_t)(512 + grp * 128 + lane) * DM + k] = (bf16_t)f2bf(ps0 * gk); pq[(size_t)(512 + grp * 128 + 64 + lane) * DM + k] = (bf16_t)f2bf(ps1 * gk); }
}

__device__ __forceinline__ void init_phase(const Args& a, int G) {
    const int tid = threadIdx.x, lane = tid & 63, wid = tid >> 6;
    const int gt = blockIdx.x * 512 + tid, NT = G * 512;
    bf16_t* W1 = (bf16_t*)(a.ws + WS_W1);
    for (int i = gt; i < 65536; i += NT) { const int r = i >> 8, col = i & 255; const int po = r >> 7, k2 = r & 127, pi = col >> 7, s2 = col & 127;
        const float ph = (float)((s2 * k2) & 127) * (1.0f / 128.0f); const float cs = cos_rev(ph), sn = sin_rev(ph);
        W1[i] = (bf16_t)f2bf(po == pi ? cs : (po == 0 ? -sn : sn)); }
#pragma unroll
    for (int v = 0; v < 2; ++v) { const int lg = 5 + v, N1 = 1 << lg; bf16_t* W2 = (bf16_t*)(a.ws + (v ? WS_W2B : WS_W2A)); const float norm = rsqrtf(128.0f * 128.0f * (float)N1);
        for (int i = gt; i < 131072; i += NT) { const int r = i >> 9, kk = i & 511; const int k2s = r >> lg, k1 = r & (N1 - 1), k2sp = kk >> (lg + 1), part = (kk >> lg) & 1, s1 = kk & (N1 - 1);
            float val = 0.f; if (k2s == k2sp) { const float ph = (float)((s1 * k1) & (N1 - 1)) / (float)N1; val = norm * (part == 0 ? cos_rev(ph) : -sin_rev(ph)); }
            W2[i] = (bf16_t)f2bf(val); } }
    bf16_t* XB = (bf16_t*)(a.ws + WS_XB); float* ssq = (float*)(a.ws + WS_SSQ);
    const int gw = blockIdx.x * 8 + wid, NGW = G * 8;
    for (int m = gw; m < MT; m += NGW) { const float* xr = (m < MH) ? a.xin[0] + (size_t)m * DM : a.xin[1] + (size_t)(m - MH) * DM;
        f32x4 v[4]; float s = 0.f;
#pragma unroll
        for (int j = 0; j < 4; ++j) { v[j] = ((const f32x4*)xr)[lane + 64 * j]; s += (v[j][0] * v[j][0] + v[j][1] * v[j][1]) + (v[j][2] * v[j][2] + v[j][3] * v[j][3]); }
        s = wave_sum(s);
#pragma unroll
        for (int j = 0; j < 4; ++j) { u32x2 w; w.x = cvt_pk_bf16(v[j][0], v[j][1]); w.y = cvt_pk_bf16(v[j][2], v[j][3]); ((u32x2*)(XB + (size_t)m * DM))[lane + 64 * j] = w; }
        if (lane < 16) ssq[(size_t)m * 16 + lane] = (lane == 0) ? s : 0.f; }
}

#define XB_TMO      128
#define XB_XCNT(j)  (256  + 64 * (j))
#define XB_XSUB(j)  (1280 + 64 * (j))
#define XB_XGEN(j)  (2304 + 64 * (j))
#define XB_TOP      3328
#define XB_TOPGEN   3392
#define XCD_BAR_WORDS 3456
#define XB_SPIN_CAP (1u << 18)

__device__ __forceinline__ unsigned xb_ld(unsigned* p)              { return __hip_atomic_load(p, __ATOMIC_RELAXED, __HIP_MEMORY_SCOPE_AGENT); }
__device__ __forceinline__ unsigned xb_add(unsigned* p, unsigned v) { return __hip_atomic_fetch_add(p, v, __ATOMIC_RELAXED, __HIP_MEMORY_SCOPE_AGENT); }
__device__ __forceinline__ unsigned xb_xcc_id() { return (unsigned)__builtin_amdgcn_s_getreg((3 << 11) | 20) & 0xFu; }
#define XB_SPIN(cond, bar) do { unsigned _sp = 0; while (cond) { __builtin_amdgcn_s_sleep(1); \
    if ((++_sp & 255u) == 0u) { if (xb_ld(&(bar)[XB_TMO])) break; if (_sp > XB_SPIN_CAP) { atomicAdd(&(bar)[XB_TMO], 1u); break; } } } } while (0)

struct XcdBarrier {
    unsigned* bar; unsigned x;
    volatile LAS unsigned* st;
};

__device__ __forceinline__ XcdBarrier xcd_barrier_post(unsigned* bar, volatile LAS unsigned* st) {
    XcdBarrier b; b.bar = bar; b.x = xb_xcc_id(); b.st = st;
    if (threadIdx.x == 0) (void)xb_add(&bar[XB_XCNT(b.x)], 1u);
    return b;
}
__device__ __forceinline__ void xcd_barrier_complete(unsigned* bar, unsigned x, unsigned& nloc, unsigned& nx) {
    const unsigned G = gridDim.x * gridDim.y * gridDim.z;
    unsigned sum, cnt, mine, sp = 0u;
    for (;;) {
        sum = 0u; cnt = 0u; mine = 0u;
#pragma unroll
        for (unsigned j = 0; j < 16; ++j) { const unsigned c = xb_ld(&bar[XB_XCNT(j)]); sum += c; cnt += (c > 0u) ? 1u : 0u; mine = (j == x) ? c : mine; }
        if (sum == G) break;
        __builtin_amdgcn_s_sleep(1);
        if ((++sp & 255u) == 0u) { if (xb_ld(&bar[XB_TMO])) break; if (sp > XB_SPIN_CAP) { atomicAdd(&bar[XB_TMO], 1u); break; } }
    }
    nloc = mine > 0u ? mine : 1u; nx = cnt > 0u ? cnt : 1u;
}

__device__ __forceinline__ void xcd_barrier(const XcdBarrier& b) {
    asm volatile("s_waitcnt vmcnt(0)" ::: "memory");
    __syncthreads();
    if (threadIdx.x == 0) {
        unsigned* bar = b.bar;
        __builtin_amdgcn_s_waitcnt(0);
        unsigned nloc = b.st[0], nx = b.st[1];
        if (nloc == 0u) { xcd_barrier_complete(bar, b.x, nloc, nx); b.st[0] = nloc; b.st[1] = nx; }
        const unsigned old = xb_add(&bar[XB_XSUB(b.x)], 1u);
        const unsigned gen = old / nloc;
        if (old + 1u == (gen + 1u) * nloc) {
            __builtin_amdgcn_fence(__ATOMIC_RELEASE, "agent");
            asm volatile("s_waitcnt vmcnt(0)" ::: "memory");
            const unsigned og = xb_add(&bar[XB_TOP], 1u);
            const unsigned tg = og / nx;
            if (og + 1u == (tg + 1u) * nx) xb_add(&bar[XB_TOPGEN], 1u);
            else XB_SPIN(xb_ld(&bar[XB_TOPGEN]) == tg, bar);
            __builtin_amdgcn_fence(__ATOMIC_ACQUIRE, "agent");
            xb_add(&bar[XB_XGEN(b.x)], 1u);
            asm volatile("s_waitcnt vmcnt(0)" ::: "memory");
        } else {
            XB_SPIN(xb_ld(&bar[XB_XGEN(b.x)]) == gen, bar);
            __builtin_amdgcn_fence(__ATOMIC_ACQUIRE, "agent");
            asm volatile("s_waitcnt vmcnt(0)" ::: "memory");
        }
    }
    __syncthreads();
}


__global__ void __launch_bounds__(512, 2) mk_fwd(Args a) {
    extern __shared__ __attribute__((aligned(16))) unsigned char lds_raw[];
    LAS unsigned char* lds = (LAS unsigned char*)lds_raw;
    cg::grid_group grid = cg::this_grid();
    const int G = gridDim.x, cb = blockIdx.x; const int vcu = (G % 8 == 0) ? (cb % 8) * (G / 8) + cb / 8 : cb;
    unsigned char* ws = a.ws; unsigned char* wt = ws + WS_WT;
    volatile LAS unsigned* MISC = (volatile LAS unsigned*)(lds + LDS_MISC);
    if (threadIdx.x < 4) MISC[threadIdx.x] = 0u;
    __syncthreads();
    if (blockIdx.x == 0) { for (int i = threadIdx.x; i < (int)(CTL_BYTES / 4); i += 512) ((unsigned*)(ws + WS_CTL))[i] = 0u; }
    init_phase(a, G);
    convert_layer(a, 0, lds, G);
    grid.sync();
    const XcdBarrier bar = xcd_barrier_post((unsigned*)(ws + WS_CTL), MISC);
    for (int l = 0; l < DEPTH; ++l) {
        if (l > 0) { convert_layer(a, l, lds, G); xcd_barrier(bar); }
        for (int half = 0; half < 2; ++half) {
            const int S = half ? 8192 : 4096, N1 = half ? 64 : 32, lgN1 = half ? 6 : 5, NB = half ? 4 : 8;
            const size_t r0 = (size_t)half * MH;
            bf16_t* XBh = (bf16_t*)(ws + WS_XB) + r0 * DM; float* ssqh = (float*)(ws + WS_SSQ) + r0 * 16; float* outh = a.out + r0 * DM;
            unsigned char* R = ws + WS_R;
            for (int step = 0; step < 3; ++step) {
                if (step != 1) {
                    const int f = step >> 1;
                    { pg8::Gemm g{XBh, (const bf16_t*)(wt + (f ? WT_FFN_IN1 : WT_FFN_IN0)), DM, DM, (size_t)128 * DM * 2, (size_t)128 * DM * 2, DM};
                      pg8::StdOrder S_; S_.init(MH, 2 * DFF, G, cb, DM, DM);
                      EpiSwiGLU E{(bf16_t*)(R + R_H), ssqh, lds};
                      pg8::gemm_phase(lds, g, S_, E); }
                    xcd_barrier(bar);
                    { pg8::Gemm g{(const bf16_t*)(R + R_H), (const bf16_t*)(wt + (f ? WT_FFN_OUT1 : WT_FFN_OUT0)), DFF, DFF, (size_t)128 * DFF * 2, (size_t)128 * DFF * 2, DFF};
                      pg8::StdOrder S_; S_.init(MH, DM, G, cb, DFF, DFF);
                      EpiResid E{XBh, ssqh, (l == DEPTH - 1 && step == 2) ? outh : nullptr, 0.5f};
                      pg8::gemm_phase(lds, g, S_, E); }
                    xcd_barrier(bar);
                } else {
                    bf16_t* QKV = (bf16_t*)(R + R_QKV); bf16_t* GA = (bf16_t*)(R + R_GA); bf16_t* GF = (bf16_t*)(R + R_GF);
                    bf16_t* D0 = (bf16_t*)(R + R_D0); bf16_t* T1P = (bf16_t*)(R + R_T1); bf16_t* AF = (bf16_t*)(R + R_AO); bf16_t* AO = AF; bf16_t* FO = AF;
                    { pg8::Gemm g{XBh, (const bf16_t*)(wt + WT_WIN), DM, DM, (size_t)128 * DM * 2, (size_t)128 * DM * 2, DM};
                      OrderWin S_{G, vcu, 0, 512};
                      EpiWin E{QKV, GA, GF, ssqh, lds};
                      pg8::gemm_phase(lds, g, S_, E); }
                    { pg8::Gemm g{(const bf16_t*)(wt + WT_PQ), XBh, DM, N1 * DM, (size_t)128 * DM * 2, (size_t)DM * 2, DM};
                      OrderPQ S_{G, vcu, N1, S};
                      EpiPQ E{D0, ssqh, N1, S};
                      pg8::gemm_phase(lds, g, S_, E); }
                    xcd_barrier(bar);
                    for (int pass = 0; pass < 2; ++pass) {
                        const bool gates_now = (pass == 0) == ((cb & 7) < 4);
                        if (gates_now) {
                            pg8::Gemm g{XBh, (const bf16_t*)(wt + WT_WIN), DM, DM, (size_t)128 * DM * 2, (size_t)128 * DM * 2, DM};
                            OrderWin S_{G, vcu, 512, 1408};
                            EpiWin E{QKV, GA, GF, ssqh, lds};
                            pg8::gemm_phase(lds, g, S_, E);
                        } else {
                            { const int nblk = S / 128; const float* qg = a.q_gain + l * 64; const float* kg = a.k_gain + l * 64; const float* sk = a.sink + l * NHEADS;
                              for (int u = vcu; u < NB * nblk * 2; u += G) { const int kvh = u & 1, bn = u >> 1; attn_unit(lds, QKV, AO, qg, kg, sk, bn / nblk, bn % nblk, kvh, S); } }
                            { pg8::Gemm g{(const bf16_t*)(ws + WS_W1), D0, 256, 256, (size_t)128 * 256 * 2, (size_t)128 * 256 * 2, 256};
                              OrderD1b S_{G, cb, vcu};
                              EpiDft1 E{T1P, N1, lgN1, S, 1.0f / (float)S};
                              pg8::gemm_phase(lds, g, S_, E); }
                        }
                    }
                    xcd_barrier(bar);
                    { pg8::Gemm g{(const bf16_t*)(ws + (half ? WS_W2B : WS_W2A)), T1P, 512, 256 * N1, (size_t)128 * 512 * 2, (size_t)128 * 256 * N1 * 2, 512};
                      OrderD2 S_{G, cb, N1};
                      EpiDft2 E{FO, N1, lgN1, S};
                      pg8::gemm_phase(lds, g, S_, E); }
                    xcd_barrier(bar);
                    { pg8::Gemm g{AF, (const bf16_t*)(wt + WT_ABR), DM, DM, (size_t)128 * DM * 2, (size_t)128 * DM * 2, DM};
                      pg8::StdOrder S_; S_.init(MH, DM, G, cb, DM, DM);
                      EpiBr E{GA, GF, T1P};
                      pg8::gemm_phase(lds, g, S_, E); }
                    xcd_barrier(bar);
                    { pg8::Gemm g{T1P, (const bf16_t*)(wt + WT_WOUT), DM, DM, (size_t)128 * DM * 2, (size_t)128 * DM * 2, DM};
                      pg8::StdOrder S_; S_.init(MH, DM, G, cb, DM, DM);
                      EpiResid E{XBh, ssqh, nullptr, 1.0f};
                      pg8::gemm_phase(lds, g, S_, E); }
                    xcd_barrier(bar);
                }
            }
        }
    }
}

extern "C" void kernel_launch(void* const* d_in, const int* in_sizes, int n_in, void* d_out, int out_size, void* d_ws, size_t ws_size, hipStream_t stream) {
    static int grid_blocks = 0;
    if (grid_blocks == 0) {
        if (n_in != 16 || out_size != MT * DM || ws_size < WS_END) { fprintf(stderr, "kernel_launch: unexpected shapes (n_in %d out %d ws %zu)\n", n_in, out_size, ws_size); grid_blocks = -1; return; }
        int dev = 0, cus = 0, per_cu = 0;
        hipGetDevice(&dev); hipDeviceGetAttribute(&cus, hipDeviceAttributeMultiprocessorCount, dev);
        hipFuncSetAttribute((const void*)mk_fwd, hipFuncAttributeMaxDynamicSharedMemorySize, LDS_BYTES);
        if (hipOccupancyMaxActiveBlocksPerMultiprocessor(&per_cu, (const void*)mk_fwd, 512, LDS_BYTES) != hipSuccess || per_cu < 1) per_cu = 1;
        (void)hipGetLastError();
        if (per_cu > 1) per_cu = 1;
        grid_blocks = cus * per_cu;
    }
    if (grid_blocks < 0) return;
    Args a{};
    a.xin[0] = (const float*)d_in[0]; a.xin[1] = (const float*)d_in[1]; a.ln_ffn1 = (const float*)d_in[2]; a.w_ffn1_in = (const float*)d_in[3]; a.w_ffn1_out = (const float*)d_in[4];
    a.ln_mix = (const float*)d_in[5]; a.w_in = (const float*)d_in[6]; a.q_gain = (const float*)d_in[7]; a.k_gain = (const float*)d_in[8]; a.sink = (const float*)d_in[9];
    a.w_attn_br = (const float*)d_in[10]; a.w_four_br = (const float*)d_in[11]; a.w_out = (const float*)d_in[12]; a.ln_ffn2 = (const float*)d_in[13];
    a.w_ffn2_in = (const float*)d_in[14]; a.w_ffn2_out = (const float*)d_in[15]; a.out = (float*)d_out; a.ws = (unsigned char*)d_ws;
    void* args[] = {&a};
    hipError_t e = hipLaunchCooperativeKernel((const void*)mk_fwd, dim3(grid_blocks), dim3(512), args, LDS_BYTES, stream);
    if (e != hipSuccess) fprintf(stderr, "cooperative launch failed: %s (grid %d)\n", hipGetErrorString(e), grid_blocks);
}
```
